# Optimizing an MI355X kernel written in HIP

```python
import jax
import jax.numpy as jnp
from jax import lax
import numpy as np

D_MODEL = 1024
BATCH = 8
SEQ = 2048
DEPTH = 2

N_MIXERS = 2
GRID_W = 64
N_MEM = 256
MEM_HEADS = 4
MEM_DH = 64
MEM_W = MEM_HEADS * MEM_DH
NA_HEADS = 12
NA_DH = 64
NA_W = NA_HEADS * NA_DH
WIN_H_MAX = 8
WIN_W = 16
ML_HEADS = 4
ML_DH = 192
ML_W = ML_HEADS * ML_DH
CONV_K = 5
CHUNK = 128
MIX_W = NA_W + MEM_W
N_EXPERTS = 16
N_GROUPS = 4
EXPERTS_PER_GROUP = N_EXPERTS // N_GROUPS
TOP_K = 2
D_EXPERT = 512
MOE_BLOCK = 128
ALPHA = (2 * DEPTH) ** 0.25
BETA = (8 * DEPTH) ** -0.25
LN_EPS = 1e-5

kernel_name = 'hybrid_natten_mlstm_moe_encoder'


def layer_norm(x, g, b):
    xf = x.astype(jnp.float32)
    mu = jnp.mean(xf, axis=-1, keepdims=True)
    var = jnp.mean(jnp.square(xf - mu), axis=-1, keepdims=True)
    return ((xf - mu) * lax.rsqrt(var + LN_EPS) * g + b).astype(x.dtype)


def memory_attention(q, mem_k, mem_v):
    B, S, _ = q.shape
    q = q.reshape(B, S, MEM_HEADS, MEM_DH) * (MEM_DH ** -0.5)
    s = jnp.einsum('bshd,bmhd->bhsm', q, mem_k, preferred_element_type=jnp.float32)
    p = jax.nn.softmax(s, axis=-1).astype(mem_v.dtype)
    return jnp.einsum('bhsm,bmhd->bshd', p, mem_v).reshape(B, S, MEM_W)


def neighbourhood_attention(q, k, v, rpb):
    B, R, W, H, Dh = q.shape
    win_h = min(WIN_H_MAX, R)
    n_cb = W // WIN_W
    span = 2 * WIN_W
    q_cols = np.arange(W).reshape(n_cb, WIN_W)
    cb_start = np.clip(np.arange(n_cb) * WIN_W - WIN_W // 2, 0, W - span)
    key_cols = cb_start[:, None] + np.arange(span)[None, :]
    col_start = np.clip(q_cols - WIN_W // 2, 0, W - WIN_W)
    kc = key_cols[:, None, :]
    col_in = (kc >= col_start[..., None]) & (kc < col_start[..., None] + WIN_W)
    dc_idx = np.clip(kc - q_cols[..., None] + WIN_W - 1, 0, 2 * WIN_W - 2)
    rpb_c = jnp.transpose(rpb[:, :, dc_idx], (0, 2, 3, 1, 4))

    def row_block(r):
        rs = jnp.clip(r - win_h // 2, 0, R - win_h)
        k_rows = lax.dynamic_slice_in_dim(k, rs, win_h, axis=1)
        v_rows = lax.dynamic_slice_in_dim(v, rs, win_h, axis=1)
        k_blk = k_rows[:, :, key_cols]
        v_blk = v_rows[:, :, key_cols]
        q_blk = lax.dynamic_index_in_dim(q, r, axis=1, keepdims=False).reshape(B, n_cb, WIN_W, H, Dh)
        s = jnp.einsum('bjqhd,brjkhd->bhjqrk', q_blk, k_blk, preferred_element_type=jnp.float32)
        dr = rs + jnp.arange(win_h) - r + WIN_H_MAX - 1
        s = s + jnp.take(rpb_c, dr, axis=3)[None].astype(jnp.float32)
        s = jnp.where(col_in[:, :, None, :], s, -jnp.inf)
        p = jax.nn.softmax(s.reshape(B, H, n_cb, WIN_W, win_h * span), axis=-1)
        p = p.reshape(s.shape).astype(v.dtype)
        o = jnp.einsum('bhjqrk,brjkhd->bjqhd', p, v_blk)
        return o.reshape(B, W, H, Dh)

    out = lax.map(row_block, jnp.arange(R))
    return jnp.moveaxis(out, 0, 1)


def na_mixer(x, w_in, rpb, mem_k, mem_v):
    B, S, _ = x.shape
    rows = S // GRID_W
    h = x @ w_in
    q, k, v, q_mem = jnp.split(h, [NA_W, 2 * NA_W, 3 * NA_W], axis=-1)
    grid = (B, rows, GRID_W, NA_HEADS, NA_DH)
    y = neighbourhood_attention(q.reshape(grid) * (NA_DH ** -0.5), k.reshape(grid), v.reshape(grid), rpb)
    return jnp.concatenate([y.reshape(B, S, NA_W), memory_attention(q_mem, mem_k, mem_v)], axis=-1)


def mlstm_chunkwise(q, k, v, i_pre, f_pre):
    q, k, v = q.astype(jnp.float32), k.astype(jnp.float32), v.astype(jnp.float32)
    B, H, S, Dk = q.shape
    Dv = v.shape[-1]
    nc = S // CHUNK
    log_f = jax.nn.log_sigmoid(f_pre.astype(jnp.float32))
    i_pre = i_pre.astype(jnp.float32)

    def to_chunks(a):
        return jnp.moveaxis(a.reshape(a.shape[:2] + (nc, CHUNK) + a.shape[3:]), 2, 0)

    causal = np.tril(np.ones((CHUNK, CHUNK), dtype=bool))

    def step(carry, inp):
        C, n, m = carry
        qb, kb, vb, ib, fb = inp
        b = jnp.cumsum(fb, axis=-1)
        d = jnp.where(causal, b[..., :, None] - b[..., None, :] + ib[..., None, :], -jnp.inf)
        inter = b + m[..., None]
        m_t = jnp.maximum(jnp.max(d, axis=-1), inter)
        dexp = jnp.exp(d - m_t[..., None])
        iexp = jnp.exp(inter - m_t)
        s = jnp.einsum('bhtd,bhsd->bhts', qb, kb) * dexp
        num = jnp.einsum('bhts,bhse->bhte', s, vb) + iexp[..., None] * jnp.einsum('bhtd,bhde->bhte', qb, C)
        den = jnp.sum(s, axis=-1) + iexp * jnp.einsum('bhtd,bhd->bht', qb, n)
        h = num / jnp.maximum(jnp.abs(den), jnp.exp(-m_t))[..., None]
        b_last = b[..., -1]
        w_s = b_last[..., None] - b + ib
        m_new = jnp.maximum(b_last + m, jnp.max(w_s, axis=-1))
        wexp = jnp.exp(w_s - m_new[..., None])
        cexp = jnp.exp(b_last + m - m_new)
        C_new = cexp[..., None, None] * C + jnp.einsum('bhs,bhsd,bhse->bhde', wexp, kb, vb)
        n_new = cexp[..., None] * n + jnp.einsum('bhs,bhsd->bhd', wexp, kb)
        return (C_new, n_new, m_new), h

    init = (jnp.zeros((B, H, Dk, Dv), jnp.float32), jnp.zeros((B, H, Dk), jnp.float32),
            jnp.zeros((B, H), jnp.float32))
    _, hs = lax.scan(step, init, (to_chunks(q), to_chunks(k), to_chunks(v), to_chunks(i_pre), to_chunks(log_f)))
    return jnp.moveaxis(hs, 0, 2).reshape(B, H, S, Dv)


def mlstm_mixer(x, w_in, conv_w, conv_b, w_qkv, gate_b, norm_g, skip, mem_k, mem_v):
    B, S, _ = x.shape
    h = x @ w_in
    xm, z, gates, q_mem = jnp.split(h, [ML_W, 2 * ML_W, 2 * ML_W + 4 * ML_HEADS], axis=-1)
    xc = lax.conv_general_dilated(xm, conv_w[:, None, :], window_strides=(1,), padding='SAME',
                                  dimension_numbers=('NWC', 'WIO', 'NWC'), feature_group_count=ML_W)
    xc = jax.nn.silu(xc + conv_b)
    xc_h = xc.reshape(B, S, ML_HEADS, ML_DH)
    xm_h = xm.reshape(B, S, ML_HEADS, ML_DH)
    q = jnp.einsum('bshd,hde->bhse', xc_h, w_qkv[0])
    k = jnp.einsum('bshd,hde->bhse', xc_h, w_qkv[1]) * (ML_DH ** -0.5)
    v = jnp.einsum('bshd,hde->bhse', xm_h, w_qkv[2])
    g = (gates.reshape(B, S, 4, ML_HEADS) + gate_b).astype(jnp.float32)
    g = jnp.transpose(g, (2, 0, 3, 1))
    h_f = mlstm_chunkwise(q, k, v, g[0], g[1])
    h_b = jnp.flip(mlstm_chunkwise(jnp.flip(q, 2), jnp.flip(k, 2), jnp.flip(v, 2),
                                   jnp.flip(g[2], -1), jnp.flip(g[3], -1)), 2)
    hs = h_f + h_b
    mu = jnp.mean(hs, axis=-1, keepdims=True)
    var = jnp.mean(jnp.square(hs - mu), axis=-1, keepdims=True)
    hs = (hs - mu) * lax.rsqrt(var + LN_EPS)
    hs = jnp.transpose(hs, (0, 2, 1, 3)).reshape(B, S, ML_W) * norm_g
    y = ((hs + skip * xc) * jax.nn.silu(z)).astype(x.dtype)
    return jnp.concatenate([y, memory_attention(q_mem, mem_k, mem_v)], axis=-1)


def moe(x, router_w, router_b, w_gate, w_up, w_down):
    B, S, D = x.shape
    N = B * S
    xf = x.reshape(N, D)
    scores = jax.nn.sigmoid(jnp.matmul(xf, router_w, preferred_element_type=jnp.float32))
    biased = scores + router_b.astype(jnp.float32)
    grp_score = jnp.sum(lax.top_k(biased.reshape(N, N_GROUPS, EXPERTS_PER_GROUP), 2)[0], axis=-1)
    g_sel = jnp.argmax(grp_score, axis=-1)
    in_group = (jnp.arange(N_EXPERTS) // EXPERTS_PER_GROUP)[None, :] == g_sel[:, None]
    _, idx = lax.top_k(jnp.where(in_group, biased, -jnp.inf), TOP_K)
    w = jnp.take_along_axis(scores, idx, axis=1)
    w = w / jnp.sum(w, axis=-1, keepdims=True)
    NK = N * TOP_K
    flat_e = idx.reshape(NK)
    order = jnp.argsort(flat_e)
    e_sorted = flat_e[order]
    tok_sorted = order // TOP_K
    counts = jnp.bincount(flat_e, length=N_EXPERTS)
    padded = (counts + MOE_BLOCK - 1) // MOE_BLOCK * MOE_BLOCK
    pad_end = jnp.cumsum(padded)
    pad_start = pad_end - padded
    start = jnp.cumsum(counts) - counts
    dest = pad_start[e_sorted] + jnp.arange(NK) - start[e_sorted]
    n_blocks = -(-NK // MOE_BLOCK) + N_EXPERTS
    buf = jnp.zeros((n_blocks * MOE_BLOCK, D), x.dtype).at[dest].set(xf[tok_sorted])
    block_e = jnp.minimum(jnp.searchsorted(pad_end, jnp.arange(n_blocks) * MOE_BLOCK, side='right'),
                          N_EXPERTS - 1)

    def expert_block(args):
        xb, e = args
        hb = jax.nn.silu(xb @ w_gate[e]) * (xb @ w_up[e])
        return hb @ w_down[e]

    y = lax.map(expert_block, (buf.reshape(n_blocks, MOE_BLOCK, D), block_e)).reshape(n_blocks * MOE_BLOCK, D)
    w_sorted = w.reshape(NK)[order].astype(x.dtype)
    out = jnp.zeros((N, D), x.dtype).at[tok_sorted].add(y[dest] * w_sorted[:, None])
    return out.reshape(B, S, D)


def setup_inputs(seed: int = 0) -> dict:
    key = jax.random.key(seed)
    ks = jax.random.split(key, 26)
    n_a = (DEPTH + 1) // 2
    n_b = DEPTH // 2

    def nrm(k, shape, scale):
        return jax.random.normal(k, shape, jnp.float32) * scale

    x = nrm(ks[0], (BATCH, SEQ, D_MODEL), 1.0)
    mem = nrm(ks[1], (BATCH, N_MEM, D_MODEL), 1.0)
    mem_ln_g = 1.0 + nrm(ks[2], (D_MODEL,), 0.05)
    mem_ln_b = nrm(ks[3], (D_MODEL,), 0.02)
    w_mem_kv = nrm(ks[4], (D_MODEL, 2 * MEM_W), D_MODEL ** -0.5).at[:, MEM_W:].multiply(BETA)
    router_w = nrm(ks[5], (D_MODEL, N_EXPERTS), D_MODEL ** -0.5)
    router_b = nrm(ks[6], (N_EXPERTS,), 0.01)
    na_w_in = nrm(ks[7], (n_a, D_MODEL, 3 * NA_W + MEM_W), D_MODEL ** -0.5)
    na_w_in = na_w_in.at[:, :, 2 * NA_W:3 * NA_W].multiply(BETA)
    na_rpb = nrm(ks[8], (n_a, NA_HEADS, 2 * WIN_H_MAX - 1, 2 * WIN_W - 1), 0.1)
    ml_w_in = nrm(ks[9], (n_b, D_MODEL, 2 * ML_W + 4 * ML_HEADS + MEM_W), D_MODEL ** -0.5)
    ml_conv_w = nrm(ks[10], (n_b, CONV_K, ML_W), CONV_K ** -0.5)
    ml_conv_b = nrm(ks[11], (n_b, ML_W), 0.02)
    ml_w_qkv = nrm(ks[12], (n_b, 3, ML_HEADS, ML_DH, ML_DH), ML_DH ** -0.5).at[:, 2].multiply(BETA)
    i_bias = nrm(ks[13], (n_b, 2, ML_HEADS), 0.1)
    f_bias = jnp.linspace(3.0, 6.0, ML_HEADS)[None, None, :] + nrm(ks[14], (n_b, 2, ML_HEADS), 0.1)
    ml_gate_b = jnp.stack([i_bias[:, 0], f_bias[:, 0], i_bias[:, 1], f_bias[:, 1]], axis=1)
    ml_norm_g = 1.0 + nrm(ks[15], (n_b, ML_W), 0.05)
    ml_skip = 1.0 + nrm(ks[16], (n_b, ML_W), 0.05)
    w_out = nrm(ks[17], (DEPTH, MIX_W, D_MODEL), MIX_W ** -0.5 * BETA)
    ln_g = 1.0 + nrm(ks[18], (DEPTH, 2, D_MODEL), 0.05)
    ln_b = nrm(ks[19], (DEPTH, 2, D_MODEL), 0.02)
    exp_w_gate = nrm(ks[20], (DEPTH, N_EXPERTS, D_MODEL, D_EXPERT), D_MODEL ** -0.5)
    exp_w_up = nrm(ks[21], (DEPTH, N_EXPERTS, D_MODEL, D_EXPERT), D_MODEL ** -0.5)
    exp_w_down = nrm(ks[22], (DEPTH, N_EXPERTS, D_EXPERT, D_MODEL), D_EXPERT ** -0.5 * BETA)
    return {'x': x, 'mem': mem, 'mem_ln_g': mem_ln_g, 'mem_ln_b': mem_ln_b, 'w_mem_kv': w_mem_kv,
            'router_w': router_w, 'router_b': router_b, 'na_w_in': na_w_in, 'na_rpb': na_rpb,
            'ml_w_in': ml_w_in, 'ml_conv_w': ml_conv_w, 'ml_conv_b': ml_conv_b, 'ml_w_qkv': ml_w_qkv,
            'ml_gate_b': ml_gate_b, 'ml_norm_g': ml_norm_g, 'ml_skip': ml_skip, 'w_out': w_out,
            'ln_g': ln_g, 'ln_b': ln_b, 'exp_w_gate': exp_w_gate, 'exp_w_up': exp_w_up,
            'exp_w_down': exp_w_down}


def reference(x, mem, mem_ln_g, mem_ln_b, w_mem_kv, router_w, router_b, na_w_in, na_rpb,
              ml_w_in, ml_conv_w, ml_conv_b, ml_w_qkv, ml_gate_b, ml_norm_g, ml_skip, w_out,
              ln_g, ln_b, exp_w_gate, exp_w_up, exp_w_down):
    B, M, _ = mem.shape
    mem_k, mem_v = jnp.split(layer_norm(mem, mem_ln_g, mem_ln_b) @ w_mem_kv, 2, axis=-1)
    mem_k = mem_k.reshape(B, M, MEM_HEADS, MEM_DH)
    mem_v = mem_v.reshape(B, M, MEM_HEADS, MEM_DH)
    for i in range(DEPTH):
        j = i // N_MIXERS
        if i % N_MIXERS == 0:
            mixed = na_mixer(x, na_w_in[j], na_rpb[j], mem_k, mem_v)
        else:
            mixed = mlstm_mixer(x, ml_w_in[j], ml_conv_w[j], ml_conv_b[j], ml_w_qkv[j], ml_gate_b[j],
                                ml_norm_g[j], ml_skip[j], mem_k, mem_v)
        x = layer_norm(ALPHA * x + mixed @ w_out[i], ln_g[i, 0], ln_b[i, 0])
        x = layer_norm(ALPHA * x + moe(x, router_w, router_b, exp_w_gate[i], exp_w_up[i], exp_w_down[i]),
                       ln_g[i, 1], ln_b[i, 1])
    return x
```

```cpp
#include <hip/hip_runtime.h>
#include <stdint.h>

namespace nv {
constexpr int D = 1024, NB = 8, S = 2048;
constexpr float ALPHA = 1.41421356237f, LN_EPS = 1e-5f;

__device__ __forceinline__ float wave_sum(float v) {
#pragma unroll
    for (int o = 1; o < 64; o <<= 1) v += __shfl_xor(v, o);
    return v;
}
__device__ __forceinline__ float wave_max(float v) {
#pragma unroll
    for (int o = 1; o < 64; o <<= 1) v = fmaxf(v, __shfl_xor(v, o));
    return v;
}
__device__ __forceinline__ float silu(float x) { return x / (1.f + expf(-x)); }

__device__ __forceinline__ void gemm_tile(const float* __restrict__ A, int lda, const int* __restrict__ arow, const float* __restrict__ Bm, const float* __restrict__ B2, int ldb,
                                          float* __restrict__ C, int ldc, int M, int N, int K, int m0, int n0) {
    __shared__ float As[16][68];
    __shared__ float Bs[16][68];
    __shared__ float Bs2[16][68];
    const int tx = threadIdx.x & 15, ty = threadIdx.x >> 4;
    float acc[4][4], acc2[4][4];
#pragma unroll
    for (int i = 0; i < 4; ++i)
#pragma unroll
        for (int j = 0; j < 4; ++j) { acc[i][j] = 0.f; acc2[i][j] = 0.f; }
    for (int k0 = 0; k0 < K; k0 += 16) {
        for (int i = threadIdx.x; i < 1024; i += 256) {
            const int m = i >> 4, k = i & 15, gm = m0 + m;
            float v = 0.f;
            if (gm < M) { const int r = arow ? arow[gm] : gm; v = A[(size_t)r * lda + k0 + k]; }
            As[k][m] = v;
        }
        for (int i = threadIdx.x; i < 1024; i += 256) {
            const int k = i >> 6, n = i & 63, gn = n0 + n;
            Bs[k][n] = gn < N ? Bm[(size_t)(k0 + k) * ldb + gn] : 0.f;
            if (B2) Bs2[k][n] = gn < N ? B2[(size_t)(k0 + k) * ldb + gn] : 0.f;
        }
        __syncthreads();
#pragma unroll
        for (int k = 0; k < 16; ++k) {
            float a[4], b[4], b2[4];
#pragma unroll
            for (int i = 0; i < 4; ++i) { a[i] = As[k][ty * 4 + i]; b[i] = Bs[k][tx * 4 + i]; b2[i] = B2 ? Bs2[k][tx * 4 + i] : 0.f; }
#pragma unroll
            for (int i = 0; i < 4; ++i)
#pragma unroll
                for (int j = 0; j < 4; ++j) { acc[i][j] += a[i] * b[j]; acc2[i][j] += a[i] * b2[j]; }
        }
        __syncthreads();
    }
#pragma unroll
    for (int i = 0; i < 4; ++i)
#pragma unroll
        for (int j = 0; j < 4; ++j) {
            const int gm = m0 + ty * 4 + i, gn = n0 + tx * 4 + j;
            if (gm < M && gn < N) C[(size_t)gm * ldc + gn] = B2 ? silu(acc[i][j]) * acc2[i][j] : acc[i][j];
        }
}

__global__ void __launch_bounds__(256) k_gemm(const float* A, int lda, const float* Bm, int ldb, float* C, int ldc, int M, int N, int K) {
    gemm_tile(A, lda, nullptr, Bm, nullptr, ldb, C, ldc, M, N, K, blockIdx.y * 64, blockIdx.x * 64);
}

__global__ void __launch_bounds__(256) k_moe_gemm1(const float* X  , const int* cnt, const int* tok  , const float* Wg, const float* Wu, float* hmid  ) {
    const int e = blockIdx.z; const int M = cnt[e]; const int m0 = blockIdx.y * 64;
    if (m0 >= M) return;
    int off = 0; for (int i = 0; i < e; ++i) off += cnt[i];
    gemm_tile(X, 1024, tok + e * 2048, Wg + (size_t)e * 1024 * 512, Wu + (size_t)e * 1024 * 512, 512, hmid + (size_t)off * 512, 512, M, 512, 1024, m0, blockIdx.x * 64);
}
__global__ void __launch_bounds__(256) k_moe_gemm2(const float* hmid, const int* cnt, const float* Wd, float* y  ) {
    const int e = blockIdx.z; const int M = cnt[e]; const int m0 = blockIdx.y * 64;
    if (m0 >= M) return;
    int off = 0; for (int i = 0; i < e; ++i) off += cnt[i];
    gemm_tile(hmid + (size_t)off * 512, 512, nullptr, Wd + (size_t)e * 512 * 1024, nullptr, 1024, y + (size_t)off * 1024, 1024, M, 1024, 512, m0, blockIdx.x * 64);
}

__device__ __forceinline__ void ln_store(float4 (&v)[4], const float* g, const float* b, float* out, int lane) {
    float s = 0.f;
#pragma unroll
    for (int j = 0; j < 4; ++j) s += (v[j].x + v[j].y) + (v[j].z + v[j].w);
    const float mean = wave_sum(s) * (1.f / 1024.f);
    float q = 0.f;
#pragma unroll
    for (int j = 0; j < 4; ++j) { v[j].x -= mean; v[j].y -= mean; v[j].z -= mean; v[j].w -= mean; q += (v[j].x * v[j].x + v[j].y * v[j].y) + (v[j].z * v[j].z + v[j].w * v[j].w); }
    const float rstd = rsqrtf(wave_sum(q) * (1.f / 1024.f) + LN_EPS);
#pragma unroll
    for (int j = 0; j < 4; ++j) {
        const float4 gg = ((const float4*)g)[lane + 64 * j], bb = ((const float4*)b)[lane + 64 * j];
        float4 o; o.x = v[j].x * rstd * gg.x + bb.x; o.y = v[j].y * rstd * gg.y + bb.y; o.z = v[j].z * rstd * gg.z + bb.z; o.w = v[j].w * rstd * gg.w + bb.w;
        ((float4*)out)[lane + 64 * j] = o;
    }
}
__global__ void __launch_bounds__(256) k_ln(const float* xres, const float* add, const float* g, const float* b, float* out, int rows) {
    const int w = (blockIdx.x * 256 + threadIdx.x) >> 6, lane = threadIdx.x & 63;
    if (w >= rows) return;
    float4 v[4];
#pragma unroll
    for (int j = 0; j < 4; ++j) {
        float4 a = ((const float4*)(add + (size_t)w * 1024))[lane + 64 * j];
        if (xres) { const float4 x = ((const float4*)(xres + (size_t)w * 1024))[lane + 64 * j]; a.x += ALPHA * x.x; a.y += ALPHA * x.y; a.z += ALPHA * x.z; a.w += ALPHA * x.w; }
        v[j] = a;
    }
    ln_store(v, g, b, out + (size_t)w * 1024, lane);
}
__global__ void __launch_bounds__(256) k_moe_combine_ln(const float* x, const float* y, const int* cnt, const int4* sel_i, const float2* sel_w, const float* g, const float* b, float* out, int rows) {
    const int w = (blockIdx.x * 256 + threadIdx.x) >> 6, lane = threadIdx.x & 63;
    if (w >= rows) return;
    const int4 si = sel_i[w]; const float2 sw = sel_w[w];
    int off0 = 0, off1 = 0;
    for (int i = 0; i < 16; ++i) { const int c = cnt[i]; if (i < si.x) off0 += c; if (i < si.z) off1 += c; }
    const float* y0 = y + (size_t)(off0 + si.y) * 1024; const float* y1 = y + (size_t)(off1 + si.w) * 1024;
    float4 v[4];
#pragma unroll
    for (int j = 0; j < 4; ++j) {
        const float4 xx = ((const float4*)(x + (size_t)w * 1024))[lane + 64 * j], a = ((const float4*)y0)[lane + 64 * j], c = ((const float4*)y1)[lane + 64 * j];
        float4 r; r.x = ALPHA * xx.x + sw.x * a.x + sw.y * c.x; r.y = ALPHA * xx.y + sw.x * a.y + sw.y * c.y; r.z = ALPHA * xx.z + sw.x * a.z + sw.y * c.z; r.w = ALPHA * xx.w + sw.x * a.w + sw.y * c.w;
        v[j] = r;
    }
    ln_store(v, g, b, out + (size_t)w * 1024, lane);
}

__global__ void __launch_bounds__(256) k_route(const float* x, const float* rw  , const float* rb, int* cnt, int* tok  , int4* sel_i, float2* sel_w, int rows) {
    const int w = (blockIdx.x * 256 + threadIdx.x) >> 6, lane = threadIdx.x & 63;
    if (w >= rows) return;
    float acc[16];
#pragma unroll
    for (int e = 0; e < 16; ++e) acc[e] = 0.f;
    for (int c = lane; c < 1024; c += 64) {
        const float xv = x[(size_t)w * 1024 + c];
        const float4* r4 = (const float4*)(rw + c * 16);
        const float4 r0 = r4[0], r1 = r4[1], r2 = r4[2], r3 = r4[3];
        acc[0] += xv * r0.x; acc[1] += xv * r0.y; acc[2] += xv * r0.z; acc[3] += xv * r0.w;
        acc[4] += xv * r1.x; acc[5] += xv * r1.y; acc[6] += xv * r1.z; acc[7] += xv * r1.w;
        acc[8] += xv * r2.x; acc[9] += xv * r2.y; acc[10] += xv * r2.z; acc[11] += xv * r2.w;
        acc[12] += xv * r3.x; acc[13] += xv * r3.y; acc[14] += xv * r3.z; acc[15] += xv * r3.w;
    }
#pragma unroll
    for (int e = 0; e < 16; ++e) acc[e] = wave_sum(acc[e]);
    if (lane == 0) {
        float bestg = -1e30f; int bi1 = 0, bi2 = 1; float bs1 = 0.f, bs2 = 0.f;
#pragma unroll
        for (int g = 0; g < 4; ++g) {
            float v1 = -1e30f, v2 = -1e30f, s1 = 0.f, s2 = 0.f; int i1 = 0, i2 = 0;
#pragma unroll
            for (int j = 0; j < 4; ++j) {
                const int e = g * 4 + j;
                const float sc = 1.f / (1.f + expf(-acc[e])); const float bv = sc + rb[e];
                if (bv > v1) { v2 = v1; i2 = i1; s2 = s1; v1 = bv; i1 = e; s1 = sc; }
                else if (bv > v2) { v2 = bv; i2 = e; s2 = sc; }
            }
            const float gs = v1 + v2;
            if (gs > bestg) { bestg = gs; bi1 = i1; bi2 = i2; bs1 = s1; bs2 = s2; }
        }
        const float inv = 1.f / (bs1 + bs2);
        const int p1 = atomicAdd(&cnt[bi1], 1), p2 = atomicAdd(&cnt[bi2], 1);
        tok[bi1 * 2048 + p1] = w; tok[bi2 * 2048 + p2] = w;
        sel_i[w] = make_int4(bi1, p1, bi2, p2); sel_w[w] = make_float2(bs1 * inv, bs2 * inv);
    }
}

__global__ void __launch_bounds__(256) k_na(const float* h0  , const float* rpb  , float* mixed  ) {
    const int w = (blockIdx.x * 256 + threadIdx.x) >> 6, lane = threadIdx.x & 63;
    if (w >= 2048 * 12) return;
    const int s = w / 12, h = w % 12;
    const float q = h0[(size_t)s * 2560 + h * 64 + lane] * 0.125f;
    const int r = s >> 6, c = s & 63;
    const int rs = min(max(r - 4, 0), 24), cs = min(max(c - 8, 0), 48);
    float sc0 = -1e30f, sc1 = -1e30f;
    for (int j = 0; j < 128; ++j) {
        const int kr = rs + (j >> 4), kc = cs + (j & 15), sp = kr * 64 + kc;
        const float kv = h0[(size_t)sp * 2560 + 768 + h * 64 + lane];
        const float sd = wave_sum(q * kv) + rpb[h * 465 + (kr - r + 7) * 31 + (kc - c + 15)];
        if ((j & 63) == lane) { if (j < 64) sc0 = sd; else sc1 = sd; }
    }
    const float m = wave_max(fmaxf(sc0, sc1));
    const float p0 = expf(sc0 - m), p1 = expf(sc1 - m);
    const float den = wave_sum(p0 + p1);
    float acc = 0.f;
    for (int j = 0; j < 128; ++j) {
        const int kr = rs + (j >> 4), kc = cs + (j & 15), sp = kr * 64 + kc;
        const float p = __shfl(j < 64 ? p0 : p1, j & 63);
        acc += p * h0[(size_t)sp * 2560 + 1536 + h * 64 + lane];
    }
    mixed[(size_t)s * 1024 + h * 64 + lane] = acc / den;
}
__global__ void __launch_bounds__(256) k_memattn(const float* hsrc, int ld, int qoff, const float* memkv  , float* mixed  ) {
    const int w = (blockIdx.x * 256 + threadIdx.x) >> 6, lane = threadIdx.x & 63;
    if (w >= 2048 * 4) return;
    const int s = w >> 2, h = w & 3;
    const float q = hsrc[(size_t)s * ld + qoff + h * 64 + lane] * 0.125f;
    float sc[4] = {-1e30f, -1e30f, -1e30f, -1e30f};
#pragma unroll
    for (int sl = 0; sl < 4; ++sl)
        for (int jj = 0; jj < 64; ++jj) {
            const int m = sl * 64 + jj;
            const float sd = wave_sum(q * memkv[(size_t)m * 512 + h * 64 + lane]);
            if (jj == lane) sc[sl] = sd;
        }
    const float mx = wave_max(fmaxf(fmaxf(sc[0], sc[1]), fmaxf(sc[2], sc[3])));
    float p[4]; float ps = 0.f;
#pragma unroll
    for (int sl = 0; sl < 4; ++sl) { p[sl] = expf(sc[sl] - mx); ps += p[sl]; }
    const float den = wave_sum(ps);
    float acc = 0.f;
#pragma unroll
    for (int sl = 0; sl < 4; ++sl)
        for (int jj = 0; jj < 64; ++jj) {
            const int m = sl * 64 + jj;
            acc += __shfl(p[sl], jj) * memkv[(size_t)m * 512 + 256 + h * 64 + lane];
        }
    mixed[(size_t)s * 1024 + 768 + h * 64 + lane] = acc / den;
}

__global__ void __launch_bounds__(256) k_conv(const float* h1  , const float* cw  , const float* cb, float* xc  ) {
    const int i = blockIdx.x * 256 + threadIdx.x;
    if (i >= 2048 * 768) return;
    const int s = i / 768, ch = i % 768;
    float a = cb[ch];
#pragma unroll
    for (int j = 0; j < 5; ++j) { const int sp = s + j - 2; if (sp >= 0 && sp < 2048) a += h1[(size_t)sp * 1808 + ch] * cw[j * 768 + ch]; }
    xc[i] = silu(a);
}
__global__ void __launch_bounds__(768) k_mlstm(const float* q, const float* k, const float* v  , const float* h1  , const float* gate_b  , float* hf, float* hb) {
    const int head = blockIdx.x & 3, dir = blockIdx.x >> 2;
    const int e = threadIdx.x % 192, part = threadIdx.x / 192;
    __shared__ float qs[192], ks[192], hp[4][192], dp[4], gIF[2];
    float C[48], n[48];
#pragma unroll
    for (int i = 0; i < 48; ++i) { C[i] = 0.f; n[i] = 0.f; }
    float* out = dir ? hb : hf;
    const float kscale = rsqrtf(192.f);
    for (int step = 0; step < 2048; ++step) {
        const int t = dir ? 2047 - step : step;
        if (threadIdx.x < 192) { qs[threadIdx.x] = q[(size_t)t * 768 + head * 192 + threadIdx.x]; ks[threadIdx.x] = k[(size_t)t * 768 + head * 192 + threadIdx.x] * kscale; }
        if (threadIdx.x == 0) {
            const float ip = h1[(size_t)t * 1808 + 1536 + (dir * 2 + 0) * 4 + head] + gate_b[(dir * 2 + 0) * 4 + head];
            const float fp = h1[(size_t)t * 1808 + 1536 + (dir * 2 + 1) * 4 + head] + gate_b[(dir * 2 + 1) * 4 + head];
            gIF[0] = expf(ip); gIF[1] = 1.f / (1.f + expf(-fp));
        }
        __syncthreads();
        const float I = gIF[0], F = gIF[1];
        const float ve = v[(size_t)t * 768 + head * 192 + e];
        float hpart = 0.f, dpart = 0.f;
#pragma unroll
        for (int i = 0; i < 48; ++i) {
            const float kd = ks[part * 48 + i], qd = qs[part * 48 + i];
            C[i] = F * C[i] + I * kd * ve; hpart += qd * C[i];
            n[i] = F * n[i] + I * kd; dpart += qd * n[i];
        }
        hp[part][e] = hpart; if (e == 0) dp[part] = dpart;
        __syncthreads();
        if (part == 0) {
            const float num = (hp[0][e] + hp[1][e]) + (hp[2][e] + hp[3][e]); const float den = (dp[0] + dp[1]) + (dp[2] + dp[3]);
            out[(size_t)t * 768 + head * 192 + e] = num / fmaxf(fabsf(den), 1.f);
        }
    }
}
__global__ void __launch_bounds__(256) k_mlstm_out(const float* hf, const float* hb, const float* xc, const float* h1, const float* norm_g, const float* skip, float* mixed) {
    const int w = (blockIdx.x * 256 + threadIdx.x) >> 6, lane = threadIdx.x & 63;
    if (w >= 2048 * 4) return;
    const int s = w >> 2, h = w & 3;
    float x[3]; float sm = 0.f;
#pragma unroll
    for (int j = 0; j < 3; ++j) { const size_t i = (size_t)s * 768 + h * 192 + lane + 64 * j; x[j] = hf[i] + hb[i]; sm += x[j]; }
    const float mean = wave_sum(sm) * (1.f / 192.f);
    float qv = 0.f;
#pragma unroll
    for (int j = 0; j < 3; ++j) { x[j] -= mean; qv += x[j] * x[j]; }
    const float rstd = rsqrtf(wave_sum(qv) * (1.f / 192.f) + LN_EPS);
#pragma unroll
    for (int j = 0; j < 3; ++j) {
        const int ch = h * 192 + lane + 64 * j;
        const float z = h1[(size_t)s * 1808 + 768 + ch];
        mixed[(size_t)s * 1024 + ch] = (x[j] * rstd * norm_g[ch] + skip[ch] * xc[(size_t)s * 768 + ch]) * silu(z);
    }
}
}

extern "C" void kernel_launch(void* const* d_in, const int* in_sizes, int n_in, void* d_out, int out_size, void* d_ws, size_t ws_size, hipStream_t stream) {
    using namespace nv;
    const float* x = (const float*)d_in[0]; const float* mem = (const float*)d_in[1]; const float* mem_g = (const float*)d_in[2]; const float* mem_b = (const float*)d_in[3];
    const float* w_mem_kv = (const float*)d_in[4]; const float* router_w = (const float*)d_in[5]; const float* router_b = (const float*)d_in[6];
    const float* na_w_in = (const float*)d_in[7]; const float* na_rpb = (const float*)d_in[8]; const float* ml_w_in = (const float*)d_in[9];
    const float* conv_w = (const float*)d_in[10]; const float* conv_b = (const float*)d_in[11]; const float* w_qkv = (const float*)d_in[12];
    const float* gate_b = (const float*)d_in[13]; const float* norm_g = (const float*)d_in[14]; const float* skip = (const float*)d_in[15];
    const float* w_out = (const float*)d_in[16]; const float* ln_g = (const float*)d_in[17]; const float* ln_b = (const float*)d_in[18];
    const float* wg = (const float*)d_in[19]; const float* wu = (const float*)d_in[20]; const float* wd = (const float*)d_in[21];
    float* out = (float*)d_out;
    char* ws = (char*)d_ws; size_t o = 0;
    auto carve = [&](size_t bytes) { char* p = ws + o; o += (bytes + 255) & ~(size_t)255; return p; };
    int* cnt = (int*)carve(16 * 16 * sizeof(int));
    float* memn = (float*)carve((size_t)2048 * 1024 * 4);
    float* memkv = (float*)carve((size_t)2048 * 512 * 4);
    float* XA = (float*)carve((size_t)16384 * 1024 * 4);
    float* XB = (float*)carve((size_t)16384 * 1024 * 4);
    float* hbuf = (float*)carve((size_t)2048 * 2560 * 4);
    float* mixed = (float*)carve((size_t)2048 * 1024 * 4);
    float* tmp = (float*)carve((size_t)2048 * 1024 * 4);
    int* tok = (int*)carve((size_t)16 * 2048 * 4);
    int4* sel_i = (int4*)carve((size_t)2048 * 16);
    float2* sel_w = (float2*)carve((size_t)2048 * 8);
    float* hmid = (float*)carve((size_t)4096 * 512 * 4);
    float* ybuf = (float*)carve((size_t)4096 * 1024 * 4);
    float* xc = (float*)carve((size_t)2048 * 768 * 4);
    float* qb = (float*)carve((size_t)2048 * 768 * 4);
    float* kb = (float*)carve((size_t)2048 * 768 * 4);
    float* vb = (float*)carve((size_t)2048 * 768 * 4);
    float* hf = (float*)carve((size_t)2048 * 768 * 4);
    float* hb = (float*)carve((size_t)2048 * 768 * 4);
    if (o > ws_size) return;
    hipMemsetAsync(cnt, 0, 16 * 16 * sizeof(int), stream);

    k_ln<<<2048 / 4, 256, 0, stream>>>(nullptr, mem, mem_g, mem_b, memn, 2048);
    k_gemm<<<dim3(512 / 64, 2048 / 64), 256, 0, stream>>>(memn, 1024, w_mem_kv, 512, memkv, 512, 2048, 512, 1024);

    auto moe = [&](int layer, int b, const float* xin  , float* xout  , const float* g, const float* bb) {
        int* c = cnt + (layer * 8 + b) * 16;
        k_route<<<2048 / 4, 256, 0, stream>>>(xin, router_w, router_b, c, tok, sel_i, sel_w, 2048);
        k_moe_gemm1<<<dim3(512 / 64, 2048 / 64, 16), 256, 0, stream>>>(xin, c, tok, wg + (size_t)layer * 16 * 1024 * 512, wu + (size_t)layer * 16 * 1024 * 512, hmid);
        k_moe_gemm2<<<dim3(1024 / 64, 2048 / 64, 16), 256, 0, stream>>>(hmid, c, wd + (size_t)layer * 16 * 512 * 1024, ybuf);
        k_moe_combine_ln<<<2048 / 4, 256, 0, stream>>>(xin, ybuf, c, sel_i, sel_w, g, bb, xout, 2048);
    };

    for (int b = 0; b < NB; ++b) {
        const float* xb = x + (size_t)b * 2048 * 1024; float* x1 = XA + (size_t)b * 2048 * 1024; float* x2 = XB + (size_t)b * 2048 * 1024;
        k_gemm<<<dim3(2560 / 64, 2048 / 64), 256, 0, stream>>>(xb, 1024, na_w_in, 2560, hbuf, 2560, 2048, 2560, 1024);
        k_na<<<2048 * 12 / 4, 256, 0, stream>>>(hbuf, na_rpb, mixed);
        k_memattn<<<2048 * 4 / 4, 256, 0, stream>>>(hbuf, 2560, 2304, memkv + (size_t)b * 256 * 512, mixed);
        k_gemm<<<dim3(1024 / 64, 2048 / 64), 256, 0, stream>>>(mixed, 1024, w_out, 1024, tmp, 1024, 2048, 1024, 1024);
        k_ln<<<2048 / 4, 256, 0, stream>>>(xb, tmp, ln_g + 0 * 1024, ln_b + 0 * 1024, x1, 2048);
        moe(0, b, x1, x2, ln_g + 1 * 1024, ln_b + 1 * 1024);
    }
    for (int b = 0; b < NB; ++b) {
        const float* x2 = XB + (size_t)b * 2048 * 1024; float* x3 = XA + (size_t)b * 2048 * 1024; float* xo = out + (size_t)b * 2048 * 1024;
        k_gemm<<<dim3((1808 + 63) / 64, 2048 / 64), 256, 0, stream>>>(x2, 1024, ml_w_in, 1808, hbuf, 1808, 2048, 1808, 1024);
        k_conv<<<2048 * 768 / 256, 256, 0, stream>>>(hbuf, conv_w, conv_b, xc);
        for (int h = 0; h < 4; ++h) {
            k_gemm<<<dim3(3, 32), 256, 0, stream>>>(xc + h * 192, 768, w_qkv + (size_t)(0 * 4 + h) * 192 * 192, 192, qb + h * 192, 768, 2048, 192, 192);
            k_gemm<<<dim3(3, 32), 256, 0, stream>>>(xc + h * 192, 768, w_qkv + (size_t)(1 * 4 + h) * 192 * 192, 192, kb + h * 192, 768, 2048, 192, 192);
            k_gemm<<<dim3(3, 32), 256, 0, stream>>>(hbuf + h * 192, 1808, w_qkv + (size_t)(2 * 4 + h) * 192 * 192, 192, vb + h * 192, 768, 2048, 192, 192);
        }
        k_mlstm<<<8, 768, 0, stream>>>(qb, kb, vb, hbuf, gate_b, hf, hb);
        k_mlstm_out<<<2048 * 4 / 4, 256, 0, stream>>>(hf, hb, xc, hbuf, norm_g, skip, mixed);
        k_memattn<<<2048 * 4 / 4, 256, 0, stream>>>(hbuf, 1808, 1552, memkv + (size_t)b * 256 * 512, mixed);
        k_gemm<<<dim3(1024 / 64, 2048 / 64), 256, 0, stream>>>(mixed, 1024, w_out + (size_t)1024 * 1024, 1024, tmp, 1024, 2048, 1024, 1024);
        k_ln<<<2048 / 4, 256, 0, stream>>>(x2, tmp, ln_g + 2 * 1024, ln_b + 2 * 1024, x3, 2048);
        moe(1, b, x3, xo, ln_g + 3 * 1024, ln_b + 3 * 1024);
    }
}
```

```cpp
#include <hip/hip_runtime.h>
#include <stdint.h>
#include <cstdio>
namespace pg8 {
#define PG8_LAS __attribute__((address_space(3)))
typedef unsigned short bf16_t;
typedef short bf16x8 __attribute__((ext_vector_type(8)));
typedef float f32x4 __attribute__((ext_vector_type(4)));
typedef unsigned u32x4 __attribute__((ext_vector_type(4)));
constexpr int BM = 256, BK = 64, HALF = 128, HTB = HALF * BK * 2  , STAGE_BYTES = 8 * HTB, NXCD = 8, WGM = 8;

__host__ __device__ __forceinline__ int lds_byte(int r, int c) { const int st = (r >> 4) * 2 + (c >> 5), rr = r & 15, cc = c & 31, ob = rr * 64 + cc * 2; return st * 1024 + (ob ^ (((ob >> 9) & 1) << 5)); }
__host__ __device__ __forceinline__ void stage_rc(int b, int& R, int& C) { const int st = b / 1024, sb = b % 1024, swz = sb ^ (((sb >> 9) & 1) << 5); R = (st >> 1) * 16 + swz / 64; C = (st & 1) * 32 + (swz % 64) / 2; }
__host__ __device__ __forceinline__ int perm32(int rho) { const int n = rho >> 4, i = rho & 15; return 8 * (i >> 2) + 4 * n + (i & 3); }

struct Unit { int pm, pn, g; };
struct Gemm { int lda, ldb, K; };

__device__ __forceinline__ unsigned cvt_pk_bf16(float lo, float hi) { unsigned r; asm volatile("v_cvt_pk_bf16_f32 %0, %1, %2" : "=v"(r) : "v"(lo), "v"(hi)); return r; }

__device__ __forceinline__ void dense_order(int L, int nM, int nN, int& pm, int& pn) {
    const int nwg = nM * nN; int wgid = L; { const int q = nwg / NXCD, r = nwg % NXCD, xcd = wgid % NXCD, off = wgid / NXCD; wgid = (xcd < r ? xcd * (q + 1) : r * (q + 1) + (xcd - r) * q) + off; }
    const int nig = WGM * nN, gid = wgid / nig, fm = gid * WGM, gsz = (nM - fm) < WGM ? (nM - fm) : WGM;
    pm = fm + ((wgid % nig) % gsz); pn = (wgid % nig) / gsz;
}
struct DenseSched {
    const char* A0; const char* B0; const char* A1; const char* B1; int nM0, nN0, nM1, nN1, G, c; size_t tA, tB;
    __device__ __forceinline__ bool next(int i, Unit& u) const {
        const int L = i * G + c, n0 = nM0 * nN0;
        if (L < n0) { dense_order(L, nM0, nN0, u.pm, u.pn); u.g = 0; return true; }
        const int r = L - n0; if (r >= nM1 * nN1) return false;
        u.pm = r % nM1; u.pn = r / nM1; u.g = 1; return true;
    }
    __device__ __forceinline__ const char* a_ptr(const Unit& u) const { return (u.g ? A1 : A0) + (size_t)u.pm * tA; }
    __device__ __forceinline__ const char* b_ptr(const Unit& u) const { return (u.g ? B1 : B0) + (size_t)u.pn * tB; }
    __device__ __forceinline__ void a_ready(const Unit&) const {}
    __device__ __forceinline__ void done(const Unit&) const {}
};
struct EpiStore {
    static constexpr bool PERM = true, AFTER_DRAIN = false;
    bf16_t* O0; int ldc0; bf16_t* O1; int ldc1;
    __device__ __forceinline__ void operator()(const f32x4 (&acc)[2][2][4][2], const Unit& u, int wr, int wc, int fr, int fq) const {
        bf16_t* base = u.g ? O1 : O0; const int ldc = u.g ? ldc1 : ldc0;
        const int row0 = u.pm * BM + wr * 64 + fr, col0 = u.pn * BM + wc * 32 + 8 * fq;
#pragma unroll
        for (int ai = 0; ai < 2; ++ai)
#pragma unroll
            for (int m = 0; m < 4; ++m) { bf16_t* rowp = base + (size_t)(row0 + ai * HALF + m * 16) * ldc + col0;
#pragma unroll
                for (int bj = 0; bj < 2; ++bj) { const f32x4 v0 = acc[ai][bj][m][0], v1 = acc[ai][bj][m][1];
                    u32x4 w; w.x = cvt_pk_bf16(v0[0], v0[1]); w.y = cvt_pk_bf16(v0[2], v0[3]); w.z = cvt_pk_bf16(v1[0], v1[1]); w.w = cvt_pk_bf16(v1[2], v1[3]);
                    *(u32x4*)(rowp + bj * HALF) = w; } }
    }
};
template <class Epi, class Sched, bool ALIGN_EPI = false, bool SP2 = false>
__device__ __forceinline__ void gemm_phase(PG8_LAS unsigned char* lds, const Gemm g, const Sched& S, const Epi& E) {
    const int tid = threadIdx.x, wid = __builtin_amdgcn_readfirstlane(tid >> 6), lane = tid & 63, wr = wid >> 2, wc = wid & 3, fr = lane & 15, fq = lane >> 4;
    const int K = g.K, nt = K / BK;
    unsigned voffA[2], voffB[2];
#pragma unroll
    for (int i = 0; i < 2; ++i) { int R, C; stage_rc(tid * 16 + i * 8192, R, C); const int Rb = Epi::PERM ? ((R & ~31) + perm32(R & 31)) : R;
        voffA[i] = (unsigned)(R * g.lda + C) * 2u; voffB[i] = (unsigned)(Rb * g.ldb + C) * 2u; }
    const size_t kstep = (size_t)(BK * 2);
    const size_t hstepA = (size_t)HALF * g.lda * 2, hstepB = (size_t)HALF * g.ldb * 2;
    const unsigned ldsw = (unsigned)wid * 1024u;
    const int aoff = lds_byte(wr * 64 + fr, fq * 8), boff = lds_byte(wc * 32 + fr, fq * 8);
#define PG8_SA(b, h) (((b) * 2 + (h)) * HTB)
#define PG8_SB(b, h) ((4 + (b) * 2 + (h)) * HTB)
#define PG8_STAGE(bufoff, gbase, voff) do { _Pragma("unroll") for (int _i = 0; _i < 2; ++_i) \
        __builtin_amdgcn_global_load_lds((const unsigned*)((const char*)(gbase) + (voff)[_i]), (PG8_LAS unsigned*)(lds + (bufoff) + ldsw + _i * 8192), 16, 0, 0); } while (0)
#define PG8_LDA(dst, b, h) do { _Pragma("unroll") for (int m = 0; m < 4; ++m) _Pragma("unroll") for (int k = 0; k < 2; ++k) dst[m][k] = *(const PG8_LAS bf16x8*)(lds + PG8_SA(b, h) + aoff + m * 2048 + k * 1024); } while (0)
#define PG8_LDB(dst, b, h) do { _Pragma("unroll") for (int n = 0; n < 2; ++n) _Pragma("unroll") for (int k = 0; k < 2; ++k) dst[n][k] = *(const PG8_LAS bf16x8*)(lds + PG8_SB(b, h) + boff + n * 2048 + k * 1024); } while (0)
#define PG8_MMA(ai, bj, At, Bt) do { __builtin_amdgcn_s_setprio(1); _Pragma("unroll") for (int m = 0; m < 4; ++m) _Pragma("unroll") for (int n = 0; n < 2; ++n) _Pragma("unroll") for (int k = 0; k < 2; ++k) \
        acc[ai][bj][m][n] = __builtin_amdgcn_mfma_f32_16x16x32_bf16(Bt[n][k], At[m][k], acc[ai][bj][m][n], 0, 0, 0); __builtin_amdgcn_s_setprio(0); } while (0)
#define PG8_WAIT_V(n) asm volatile("s_waitcnt vmcnt(" #n ")" ::: "memory")
#define PG8_WAIT_L(n) asm volatile("s_waitcnt lgkmcnt(" #n ")" ::: "memory")
#define PG8_BAR __builtin_amdgcn_s_barrier()
#define PG8_SCHED __builtin_amdgcn_sched_barrier(0)
    Unit cur, nxt; int ui = 0;
    if (!S.next(0, cur)) return;
    f32x4 acc[2][2][4][2];
#pragma unroll
    for (int a = 0; a < 2; ++a)
#pragma unroll
        for (int b = 0; b < 2; ++b)
#pragma unroll
            for (int m = 0; m < 4; ++m)
#pragma unroll
                for (int n = 0; n < 2; ++n) acc[a][b][m][n] = (f32x4){0.f, 0.f, 0.f, 0.f};
    bf16x8 At[4][2], B0[2][2], B1[2][2];
    const char* cA = S.a_ptr(cur); const char* cB = S.b_ptr(cur);
    S.a_ready(cur);
    if constexpr (SP2) {
        PG8_STAGE(PG8_SB(0, 0), cB, voffB); PG8_STAGE(PG8_SB(0, 1), cB + hstepB, voffB); PG8_STAGE(PG8_SA(0, 0), cA, voffA); PG8_STAGE(PG8_SA(0, 1), cA + hstepA, voffA);
        if (wr == 1) PG8_BAR;
        PG8_WAIT_V(2); PG8_BAR;
        PG8_STAGE(PG8_SB(1, 0), cB + kstep, voffB); PG8_STAGE(PG8_SA(1, 0), cA + kstep, voffA); PG8_STAGE(PG8_SB(1, 1), cB + hstepB + kstep, voffB);
        PG8_WAIT_V(6); PG8_BAR;
    } else {
        PG8_STAGE(PG8_SB(0, 0), cB, voffB); PG8_STAGE(PG8_SA(0, 0), cA, voffA); PG8_STAGE(PG8_SB(0, 1), cB + hstepB, voffB); PG8_STAGE(PG8_SA(0, 1), cA + hstepA, voffA);
        if (wr == 1) PG8_BAR;
        PG8_WAIT_V(4); PG8_BAR;
        PG8_STAGE(PG8_SB(1, 0), cB + kstep, voffB); PG8_STAGE(PG8_SA(1, 0), cA + kstep, voffA); PG8_STAGE(PG8_SB(1, 1), cB + hstepB + kstep, voffB);
        PG8_WAIT_V(6); PG8_BAR;
    }
    for (;;) {
        const bool has_next = S.next(ui + 1, nxt);
        const char* nA = has_next ? S.a_ptr(nxt) : cA; const char* nB = has_next ? S.b_ptr(nxt) : cB;
        for (int t = 0; t < nt; t += 2) {
            const bool last = (t == nt - 2);
            const char* a1 = cA + (size_t)(t + 1) * kstep;
            const char* a2 = last ? nA : cA + (size_t)(t + 2) * kstep; const char* b2 = last ? nB : cB + (size_t)(t + 2) * kstep;
            const char* a3 = a2 + kstep; const char* b3 = b2 + kstep;
            if (last && has_next) S.a_ready(nxt);
            if constexpr (SP2) {
            PG8_LDB(B0, 0, 0); PG8_LDB(B1, 0, 1); PG8_SCHED; PG8_LDA(At, 0, 0); PG8_STAGE(PG8_SA(1, 1), a1 + hstepA, voffA);
            PG8_WAIT_V(8); PG8_WAIT_L(0); PG8_BAR; PG8_MMA(0, 0, At, B0); PG8_MMA(0, 1, At, B1); PG8_BAR; PG8_SCHED;
            PG8_LDA(At, 0, 1); PG8_STAGE(PG8_SB(0, 0), b2, voffB); PG8_STAGE(PG8_SB(0, 1), b2 + hstepB, voffB); PG8_STAGE(PG8_SA(0, 0), a2, voffA);
            PG8_WAIT_V(8); PG8_WAIT_L(0); PG8_BAR; PG8_MMA(1, 0, At, B0); PG8_MMA(1, 1, At, B1); PG8_BAR; PG8_SCHED;
            PG8_LDB(B0, 1, 0); PG8_LDB(B1, 1, 1); PG8_SCHED; PG8_LDA(At, 1, 0); PG8_STAGE(PG8_SA(0, 1), a2 + hstepA, voffA);
            PG8_WAIT_V(8); PG8_WAIT_L(0); PG8_BAR; PG8_MMA(0, 0, At, B0); PG8_MMA(0, 1, At, B1); PG8_BAR; PG8_SCHED;
            PG8_LDA(At, 1, 1); PG8_STAGE(PG8_SB(1, 0), b3, voffB); PG8_STAGE(PG8_SB(1, 1), b3 + hstepB, voffB); PG8_STAGE(PG8_SA(1, 0), a3, voffA);
            PG8_WAIT_V(8); PG8_WAIT_L(0); PG8_BAR; PG8_MMA(1, 0, At, B0); PG8_MMA(1, 1, At, B1); PG8_BAR; PG8_SCHED;
            } else {
            PG8_LDB(B0, 0, 0); PG8_SCHED; PG8_LDA(At, 0, 0); PG8_STAGE(PG8_SA(1, 1), a1 + hstepA, voffA);
            PG8_WAIT_L(8); PG8_BAR; PG8_WAIT_L(0); PG8_MMA(0, 0, At, B0); PG8_BAR; PG8_SCHED;
            PG8_LDB(B1, 0, 1); PG8_STAGE(PG8_SB(0, 0), b2, voffB);
            PG8_BAR; PG8_WAIT_L(0); PG8_MMA(0, 1, At, B1); PG8_BAR;
            PG8_LDA(At, 0, 1); PG8_STAGE(PG8_SA(0, 0), a2, voffA);
            PG8_BAR; PG8_WAIT_L(0); PG8_MMA(1, 0, At, B0); PG8_BAR; PG8_SCHED;
            PG8_STAGE(PG8_SB(0, 1), b2 + hstepB, voffB);
            PG8_WAIT_V(6); PG8_BAR; PG8_MMA(1, 1, At, B1); PG8_BAR;
            PG8_LDB(B0, 1, 0); PG8_SCHED; PG8_LDA(At, 1, 0); PG8_STAGE(PG8_SA(0, 1), a2 + hstepA, voffA);
            PG8_WAIT_L(8); PG8_BAR; PG8_WAIT_L(0); PG8_MMA(0, 0, At, B0); PG8_BAR; PG8_SCHED;
            PG8_LDB(B1, 1, 1); PG8_STAGE(PG8_SB(1, 0), b3, voffB);
            PG8_BAR; PG8_WAIT_L(0); PG8_MMA(0, 1, At, B1); PG8_BAR;
            PG8_LDA(At, 1, 1); PG8_STAGE(PG8_SA(1, 0), a3, voffA);
            PG8_BAR; PG8_WAIT_L(0); PG8_MMA(1, 0, At, B0); PG8_BAR; PG8_SCHED;
            PG8_STAGE(PG8_SB(1, 1), b3 + hstepB, voffB);
            PG8_WAIT_V(6); PG8_BAR; PG8_MMA(1, 1, At, B1); PG8_BAR;
            }
        }
        if constexpr (ALIGN_EPI) { if (wr == 0) PG8_BAR; }
        if constexpr (!Epi::AFTER_DRAIN) { E(acc, cur, wr, wc, fr, fq); S.done(cur); }
        if (!has_next) break;
#pragma unroll
        for (int a = 0; a < 2; ++a)
#pragma unroll
            for (int b = 0; b < 2; ++b)
#pragma unroll
                for (int m = 0; m < 4; ++m)
#pragma unroll
                    for (int n = 0; n < 2; ++n) acc[a][b][m][n] = (f32x4){0.f, 0.f, 0.f, 0.f};
        cur = nxt; cA = nA; cB = nB; ++ui;
        if constexpr (ALIGN_EPI) { if (wr == 1) PG8_BAR; }
    }
    PG8_WAIT_V(0);
    if constexpr (!ALIGN_EPI) { if (wr == 0) PG8_BAR; }
    PG8_BAR;
    if constexpr (Epi::AFTER_DRAIN) { E.fused(acc, cur, wr, wc, fr, fq, lds, wid, lane); S.done(cur); }
#undef PG8_SA
#undef PG8_SB
#undef PG8_STAGE
#undef PG8_LDA
#undef PG8_LDB
#undef PG8_MMA
#undef PG8_WAIT_V
#undef PG8_WAIT_L
#undef PG8_BAR
#undef PG8_SCHED
}
}
namespace mk {
constexpr int NWAVES = 8, NTHREADS = 512;
constexpr int D = 1024, NTOK = 16384, SEQ = 2048, NBATCH = 8;
constexpr float ALPHA = 1.41421356237f, LN_EPS = 1e-5f;
constexpr size_t MiB = 1u << 20;
constexpr size_t WS_CTL = 0, CTL_ZERO_BYTES = 1 * MiB;
constexpr size_t WS_WIN0 = 1 * MiB;
constexpr size_t WS_WMKV = 6 * MiB;
constexpr size_t WS_WIN1 = 7 * MiB;
constexpr size_t WS_WOUT = 11 * MiB;
constexpr size_t WS_WQKV = 15 * MiB;
constexpr size_t WS_MEMN = 16 * MiB;
constexpr size_t WS_MEMKV = 20 * MiB;
constexpr size_t WS_ROUTE = 22 * MiB;
constexpr size_t WS_WEXP = 26 * MiB;
constexpr size_t WS_XBF = 74 * MiB;
constexpr size_t WS_R1 = 106 * MiB;
constexpr size_t WS_R3 = 186 * MiB;
constexpr size_t WS_END = 258 * MiB;
constexpr int CW_BAR = 4096;
constexpr int LDS_BYTES = 163840, LDSCTL_OFF = LDS_BYTES - 512, MISC_OFF = LDSCTL_OFF + 320;

#define GAS __attribute__((address_space(1)))
#define LAS __attribute__((address_space(3)))
typedef unsigned short bf16;
typedef unsigned v4u __attribute__((ext_vector_type(4)));
typedef unsigned v2u __attribute__((ext_vector_type(2)));
typedef float f32x4 __attribute__((ext_vector_type(4)));
typedef short bf16x8 __attribute__((ext_vector_type(8)));
typedef GAS unsigned gu32;
#define RLX_AGENT __ATOMIC_RELAXED, __HIP_MEMORY_SCOPE_AGENT
#define LDS_WAIT() asm volatile("s_waitcnt lgkmcnt(0)" ::: "memory")
#define VM_WAIT() asm volatile("s_waitcnt vmcnt(0)" ::: "memory")
__device__ __forceinline__ unsigned f2bf(float f) { unsigned u = __builtin_bit_cast(unsigned, f); return (u + 0x7fffu + ((u >> 16) & 1u)) >> 16; }
__device__ __forceinline__ unsigned pk2(float lo, float hi) { return f2bf(lo) | (f2bf(hi) << 16); }
__device__ __forceinline__ float bf2f(unsigned short b) { return __builtin_bit_cast(float, (unsigned)b << 16); }
__device__ __forceinline__ float bflo(unsigned w) { return __builtin_bit_cast(float, w << 16); }
__device__ __forceinline__ float bfhi(unsigned w) { return __builtin_bit_cast(float, w & 0xffff0000u); }

#define XB_TMO      128
#define XB_XCNT(j)  (256  + 64 * (j))
#define XB_XSUB(j)  (1280 + 64 * (j))
#define XB_XGEN(j)  (2304 + 64 * (j))
#define XB_TOP      3328
#define XB_TOPGEN   3392
#define XCD_BAR_WORDS 3456
#define XB_SPIN_CAP (1u << 18)
__device__ __forceinline__ unsigned xb_ld(unsigned* p)              { return __hip_atomic_load(p, __ATOMIC_RELAXED, __HIP_MEMORY_SCOPE_AGENT); }
__device__ __forceinline__ unsigned xb_add(unsigned* p, unsigned v) { return __hip_atomic_fetch_add(p, v, __ATOMIC_RELAXED, __HIP_MEMORY_SCOPE_AGENT); }
__device__ __forceinline__ unsigned xb_xcc_id() { return (unsigned)__builtin_amdgcn_s_getreg((3 << 11) | 20) & 0xFu; }
#define XB_SPIN(cond, bar) do { unsigned _sp = 0; while (cond) { __builtin_amdgcn_s_sleep(1); \
    if ((++_sp & 255u) == 0u) { if (xb_ld(&(bar)[XB_TMO])) break; if (_sp > XB_SPIN_CAP) { atomicAdd(&(bar)[XB_TMO], 1u); break; } } } } while (0)
struct XcdBarrier { unsigned* bar; unsigned x; volatile LAS unsigned* st; };
__device__ __forceinline__ XcdBarrier xcd_barrier_post(unsigned* bar, volatile LAS unsigned* st) {
    XcdBarrier b; b.bar = bar; b.x = xb_xcc_id(); b.st = st;
    if (threadIdx.x == 0) (void)xb_add(&bar[XB_XCNT(b.x)], 1u);
    return b;
}
__device__ __forceinline__ void xcd_barrier_complete(unsigned* bar, unsigned x, unsigned& nloc, unsigned& nx) {
    const unsigned G = gridDim.x * gridDim.y * gridDim.z;
    unsigned sum, cnt, mine, sp = 0u;
    for (;;) {
        sum = 0u; cnt = 0u; mine = 0u;
#pragma unroll
        for (unsigned j = 0; j < 16; ++j) { const unsigned c = xb_ld(&bar[XB_XCNT(j)]); sum += c; cnt += (c > 0u) ? 1u : 0u; mine = (j == x) ? c : mine; }
        if (sum == G) break;
        __builtin_amdgcn_s_sleep(1);
        if ((++sp & 255u) == 0u) { if (xb_ld(&bar[XB_TMO])) break; if (sp > XB_SPIN_CAP) { atomicAdd(&bar[XB_TMO], 1u); break; } }
    }
    nloc = mine > 0u ? mine : 1u; nx = cnt > 0u ? cnt : 1u;
}
__device__ __forceinline__ void xcd_barrier(const XcdBarrier& b) {
    asm volatile("s_waitcnt vmcnt(0)" ::: "memory");
    __syncthreads();
    if (threadIdx.x == 0) {
        unsigned* bar = b.bar;
        __builtin_amdgcn_s_waitcnt(0);
        unsigned nloc = b.st[0], nx = b.st[1];
        if (nloc == 0u) { xcd_barrier_complete(bar, b.x, nloc, nx); b.st[0] = nloc; b.st[1] = nx; }
        const unsigned old = xb_add(&bar[XB_XSUB(b.x)], 1u);
        const unsigned gen = old / nloc;
        if (old + 1u == (gen + 1u) * nloc) {
            __builtin_amdgcn_fence(__ATOMIC_RELEASE, "agent");
            asm volatile("s_waitcnt vmcnt(0)" ::: "memory");
            const unsigned og = xb_add(&bar[XB_TOP], 1u);
            const unsigned tg = og / nx;
            if (og + 1u == (tg + 1u) * nx) xb_add(&bar[XB_TOPGEN], 1u);
            else XB_SPIN(xb_ld(&bar[XB_TOPGEN]) == tg, bar);
            __builtin_amdgcn_fence(__ATOMIC_ACQUIRE, "agent");
            xb_add(&bar[XB_XGEN(b.x)], 1u);
            asm volatile("s_waitcnt vmcnt(0)" ::: "memory");
        } else {
            XB_SPIN(xb_ld(&bar[XB_XGEN(b.x)]) == gen, bar);
            __builtin_amdgcn_fence(__ATOMIC_ACQUIRE, "agent");
            asm volatile("s_waitcnt vmcnt(0)" ::: "memory");
        }
    }
    __syncthreads();
}

struct Args { const float* in[22]; float* out; unsigned char* ws; int ph_lo, ph_hi, li, pad; };
struct Frame {
    LAS unsigned char* lds; volatile LAS unsigned* MISC; gu32* ctl;
    int tid, lane, wave, vcu, G;
};
__device__ __forceinline__ float wave_sum(float v) {
#pragma unroll
    for (int o = 1; o < 64; o <<= 1) v += __shfl_xor(v, o);
    return v;
}

__device__ __forceinline__ void p0_tr_item(const float* W, int ldw, int col0, bf16* WT, int K, int drow0, float scale, LAS float* scr, int kb, int nb, int lane) {
    const int k0 = 64 * kb, n0 = 32 * nb;
#pragma unroll 8
    for (int i = 0; i < 32; ++i) { const int kk = 2 * i + (lane >> 5); scr[kk * 33 + (lane & 31)] = W[(size_t)(k0 + kk) * ldw + col0 + n0 + (lane & 31)] * scale; }
    LDS_WAIT(); asm volatile("" ::: "memory");
    const int c = lane & 7;
#pragma unroll
    for (int j = 0; j < 4; ++j) { const int n = (lane >> 3) + 8 * j; const LAS float* s = scr + (8 * c) * 33 + n;
        v4u o; o.x = pk2(s[0 * 33], s[1 * 33]); o.y = pk2(s[2 * 33], s[3 * 33]); o.z = pk2(s[4 * 33], s[5 * 33]); o.w = pk2(s[6 * 33], s[7 * 33]);
        *(GAS v4u*)(WT + (size_t)(drow0 + n0 + n) * K + k0 + 8 * c) = o; }
    LDS_WAIT(); asm volatile("" ::: "memory");
}
__device__ __forceinline__ bool p0_seg(int& it, const float* W, int ldw, int col0, int ncols, int K, bf16* WT, int drow0, float scale, LAS float* scr, int lane) {
    const int nblk = ncols / 32, items = (K / 64) * nblk;
    if (it < items) { p0_tr_item(W, ldw, col0, WT, K, drow0, scale, scr, it / nblk, it % nblk, lane); return true; }
    it -= items; return false;
}
__device__ __forceinline__ void p0_experts(const Frame& F, const float* wg, const float* wu, const float* wd, bf16* WGU, bf16* WD, int gw0, int ngw) {
    LAS float* scr = (LAS float*)(F.lds + F.wave * 16384);
    constexpr int I_GU = 16 * 16, I_D = 8 * 32;
    constexpr int PER_E = 2 * I_GU + I_D, TOTAL = 16 * PER_E;
    for (int it = gw0; it < TOTAL; it += ngw) {
        const int e = it / PER_E; int r = it % PER_E;
        if (r < 2 * I_GU) {
            const int up = r / I_GU; r %= I_GU; const int kb = r / 16, nb = r % 16;
            const float* src = (up ? wu : wg) + (size_t)e * 1024 * 512;
            const int c0 = nb * 32, drow = (c0 / 128) * 256 + up * 128 + (c0 % 128);
            p0_tr_item(src, 512, c0, WGU + (size_t)e * 1024 * 1024, 1024, drow, 1.f, scr, kb, 0, F.lane);
        } else {
            r -= 2 * I_GU; const int kb = r / 32, nb = r % 32;
            p0_tr_item(wd + (size_t)e * 512 * 1024, 1024, 0, WD + (size_t)e * 1024 * 512, 512, 0, 1.f, scr, kb, nb, F.lane);
        }
    }
}
__device__ __forceinline__ void p0_prologue(const Frame& F, const Args& a) {
    unsigned char* ws = a.ws;
    LAS float* scr = (LAS float*)(F.lds + F.wave * 16384);
    const int gw = F.vcu * NWAVES + F.wave, NGW = F.G * NWAVES;
    bf16* WIN0 = (bf16*)(ws + WS_WIN0); bf16* WMKV = (bf16*)(ws + WS_WMKV); bf16* WIN1 = (bf16*)(ws + WS_WIN1); bf16* WOUT = (bf16*)(ws + WS_WOUT); bf16* WQKV = (bf16*)(ws + WS_WQKV);
    const float* na_w_in = a.in[7]; const float* w_mem_kv = a.in[4]; const float* ml_w_in = a.in[9]; const float* w_out = a.in[16]; const float* w_qkv = a.in[12];
    constexpr int N_MISC = 16 * (80 + 16 + 56 + 64) + 12 * 18;
    for (int it0 = gw; it0 < N_MISC; it0 += NGW) {
        int it = it0;
        if (p0_seg(it, na_w_in, 2560, 0, 768, 1024, WIN0, 0, 0.125f, scr, F.lane)) continue;
        if (p0_seg(it, na_w_in, 2560, 2304, 256, 1024, WIN0, 768, 0.125f, scr, F.lane)) continue;
        if (p0_seg(it, na_w_in, 2560, 768, 768, 1024, WIN0, 1024, 1.f, scr, F.lane)) continue;
        if (p0_seg(it, na_w_in, 2560, 1536, 768, 1024, WIN0, 1792, 1.f, scr, F.lane)) continue;
        if (p0_seg(it, w_mem_kv, 512, 0, 512, 1024, WMKV, 0, 1.f, scr, F.lane)) continue;
        if (p0_seg(it, ml_w_in, 1808, 0, 768, 1024, WIN1, 0, 1.f, scr, F.lane)) continue;
        if (p0_seg(it, ml_w_in, 1808, 1552, 256, 1024, WIN1, 768, 0.125f, scr, F.lane)) continue;
        if (p0_seg(it, ml_w_in, 1808, 768, 768, 1024, WIN1, 1024, 1.f, scr, F.lane)) continue;
        if (p0_seg(it, w_out, 1024, 0, 1024, 1024, WOUT, 0, 1.f, scr, F.lane)) continue;
        if (p0_seg(it, w_out + (size_t)1024 * 1024, 1024, 0, 1024, 1024, WOUT + (size_t)1024 * 1024, 0, 1.f, scr, F.lane)) continue;
        { const int m = it / 18, r = it % 18; const int mat = m / 4;
          p0_tr_item(w_qkv + (size_t)m * 192 * 192, 192, 0, WQKV + (size_t)m * 192 * 192, 192, 0, mat == 1 ? 0.07216878364870322f : 1.f, scr, r / 6, r % 6, F.lane); }
    }
    p0_experts(F, a.in[19], a.in[20], a.in[21], (bf16*)(ws + WS_WEXP), (bf16*)(ws + WS_WEXP + 32 * MiB), gw, NGW);
    const float* x = a.in[0]; bf16* XBF = (bf16*)(ws + WS_XBF);
    for (int m = gw; m < NTOK; m += NGW) {
        const GAS f32x4* xr = (const GAS f32x4*)(x + (size_t)m * D) + F.lane; GAS unsigned long long* o8 = (GAS unsigned long long*)(XBF + (size_t)m * D) + F.lane;
#pragma unroll
        for (int j = 0; j < 4; ++j) { const f32x4 v = xr[64 * j]; o8[64 * j] = (unsigned long long)pk2(v.x, v.y) | ((unsigned long long)pk2(v.z, v.w) << 32); }
    }
    const float* mem = a.in[1]; const float* mg = a.in[2]; const float* mb = a.in[3]; bf16* MEMN = (bf16*)(ws + WS_MEMN);
    for (int m = gw; m < 2048; m += NGW) {
        const GAS f32x4* xr = (const GAS f32x4*)(mem + (size_t)m * D) + F.lane;
        f32x4 v[4]; float s = 0.f;
#pragma unroll
        for (int j = 0; j < 4; ++j) { v[j] = xr[64 * j]; s += (v[j].x + v[j].y) + (v[j].z + v[j].w); }
        const float mean = wave_sum(s) * (1.f / D); float s2 = 0.f;
#pragma unroll
        for (int j = 0; j < 4; ++j) { v[j] = v[j] - mean; s2 += (v[j].x * v[j].x + v[j].y * v[j].y) + (v[j].z * v[j].z + v[j].w * v[j].w); }
        const float rstd = 1.f / sqrtf(wave_sum(s2) * (1.f / D) + LN_EPS);
        GAS unsigned long long* o8 = (GAS unsigned long long*)(MEMN + (size_t)m * D) + F.lane;
#pragma unroll
        for (int j = 0; j < 4; ++j) { const f32x4 g = ((const GAS f32x4*)mg)[F.lane + 64 * j], b = ((const GAS f32x4*)mb)[F.lane + 64 * j]; const f32x4 o = v[j] * rstd * g + b;
            o8[64 * j] = (unsigned long long)pk2(o.x, o.y) | ((unsigned long long)pk2(o.z, o.w) << 32); }
    }
}

typedef float f32x2_t __attribute__((ext_vector_type(2)));
typedef __bf16 bf16x2_t __attribute__((ext_vector_type(2)));
typedef short s16x4 __attribute__((ext_vector_type(4)));
__device__ __forceinline__ unsigned cvtpk(float lo, float hi) { f32x2_t v = {lo, hi}; bf16x2_t b = __builtin_convertvector(v, bf16x2_t); return __builtin_bit_cast(unsigned, b); }
#define MFMA16(a, b, c) __builtin_amdgcn_mfma_f32_16x16x32_bf16((a), (b), (c), 0, 0, 0)

template <bool NA>
__device__ __forceinline__ void attn16(LAS const unsigned char* lds, const int (&kofs)[8], const int (&vofs)[8], int vpitch, const bf16x8 (&qf)[2], int cq, int g, int swz,
                                       LAS const float* tab, const int (&drow)[8], const int (&dcb)[2][4], unsigned vmask, f32x4 (&o)[4], float& linv) {
    f32x4 s[8][2];
    const int c0 = (g ^ swz) << 4, c1 = ((g + 4) ^ swz) << 4;
#pragma unroll
    for (int kg = 0; kg < 8; ++kg)
#pragma unroll
        for (int t = 0; t < 2; ++t) {
            const int ra = kofs[kg] + (16 * t + cq) * 128;
            const bf16x8 k0 = *(LAS const bf16x8*)(lds + ra + c0), k1 = *(LAS const bf16x8*)(lds + ra + c1);
            f32x4 z = {0.f, 0.f, 0.f, 0.f};
            z = MFMA16(k0, qf[0], z); s[kg][t] = MFMA16(k1, qf[1], z);
        }
    float m = -1e30f;
#pragma unroll
    for (int kg = 0; kg < 8; ++kg)
#pragma unroll
        for (int t = 0; t < 2; ++t)
#pragma unroll
            for (int i = 0; i < 4; ++i) {
                float v = s[kg][t][i];
                if (NA) { v += tab[drow[kg] + dcb[t][i]]; v = ((vmask >> (t * 4 + i)) & 1u) ? v : -1e30f; }
                s[kg][t][i] = v; m = fmaxf(m, v);
            }
    m = fmaxf(m, __shfl_xor(m, 16)); m = fmaxf(m, __shfl_xor(m, 32));
    float l = 0.f;
#pragma unroll
    for (int kg = 0; kg < 8; ++kg)
#pragma unroll
        for (int t = 0; t < 2; ++t)
#pragma unroll
            for (int i = 0; i < 4; ++i) { const float p = __expf(s[kg][t][i] - m); s[kg][t][i] = p; l += p; }
    l += __shfl_xor(l, 16); l += __shfl_xor(l, 32);
    linv = 1.f / l;
#pragma unroll
    for (int dt = 0; dt < 4; ++dt) o[dt] = (f32x4){0.f, 0.f, 0.f, 0.f};
#pragma unroll
    for (int kg = 0; kg < 8; ++kg) {
        v4u pw; pw.x = cvtpk(s[kg][0][0], s[kg][0][1]); pw.y = cvtpk(s[kg][0][2], s[kg][0][3]); pw.z = cvtpk(s[kg][1][0], s[kg][1][1]); pw.w = cvtpk(s[kg][1][2], s[kg][1][3]);
        const bf16x8 pf = __builtin_bit_cast(bf16x8, pw);
#pragma unroll
        for (int dt = 0; dt < 4; ++dt) {
            const int va = vofs[kg] + (16 * dt + cq) * vpitch + 8 * g;
            const s16x4 lo = *(LAS const s16x4*)(lds + va), hi = *(LAS const s16x4*)(lds + va + 32);
            const bf16x8 vf = __builtin_shufflevector(lo, hi, 0, 1, 2, 3, 4, 5, 6, 7);
            o[dt] = MFMA16(vf, pf, o[dt]);
        }
    }
}
__device__ __forceinline__ void attn_store(bf16* dst  , const f32x4 (&o)[4], float linv, int g) {
#pragma unroll
    for (int dt = 0; dt < 4; ++dt) { v2u w; w.x = cvtpk(o[dt][0] * linv, o[dt][1] * linv); w.y = cvtpk(o[dt][2] * linv, o[dt][3] * linv); *(GAS v2u*)(dst + 16 * dt + 4 * g) = w; }
}

constexpr int NA_KR = 0, NA_VR = 9 * 8192, NA_VSLOT = 64 * 136, NA_TAB = NA_VR + 9 * NA_VSLOT;
static_assert(NA_TAB + 2048 <= LDSCTL_OFF, "NA LDS map");
__device__ __forceinline__ int na_rs(int r) { return min(max(r - 4, 0), 24); }
__device__ __forceinline__ void na_row_write(const Frame& F, int R, v4u kv, v4u vv) {
    const int col = F.tid >> 3, chunk = F.tid & 7, slot = R % 9;
    *(LAS v4u*)(F.lds + NA_KR + slot * 8192 + col * 128 + ((chunk ^ (col & 7)) << 4)) = kv;
    LAS unsigned short* vt = (LAS unsigned short*)(F.lds + NA_VR + slot * NA_VSLOT) + (chunk * 8) * 68 + col;
    vt[0 * 68] = (unsigned short)(vv.x & 0xffff); vt[1 * 68] = (unsigned short)(vv.x >> 16); vt[2 * 68] = (unsigned short)(vv.y & 0xffff); vt[3 * 68] = (unsigned short)(vv.y >> 16);
    vt[4 * 68] = (unsigned short)(vv.z & 0xffff); vt[5 * 68] = (unsigned short)(vv.z >> 16); vt[6 * 68] = (unsigned short)(vv.w & 0xffff); vt[7 * 68] = (unsigned short)(vv.w >> 16);
}
__device__ __forceinline__ void na_item(const Frame& F, bf16* H0, const float* rpb, int b, int h, int half) {
    const int cq = F.lane & 15, g = F.lane >> 4, j = F.wave & 3, wrow = F.wave >> 2;
    LAS float* tab = (LAS float*)(F.lds + NA_TAB);
    if (F.tid < 465) tab[F.tid] = rpb[h * 465 + F.tid];
    const int col = F.tid >> 3, chunk = F.tid & 7;
    const bf16* kvsrc = H0 + (size_t)(b * 2048 + col) * 2560 + 1024 + h * 64 + chunk * 8;
    const int r0 = 16 * half;
    int hi = na_rs(r0 + 1) + 7;
    for (int R = na_rs(r0); R <= hi; ++R) {
        const v4u kv = *(const GAS v4u*)(kvsrc + (size_t)R * 64 * 2560), vv = *(const GAS v4u*)(kvsrc + (size_t)R * 64 * 2560 + 768);
        na_row_write(F, R, kv, vv);
    }
    __syncthreads();
    const int cb = min(max(16 * j - 8, 0), 32), c = 16 * j + cq, cs = min(max(c - 8, 0), 48);
    int dcb[2][4]; unsigned vmask = 0u;
#pragma unroll
    for (int t = 0; t < 2; ++t)
#pragma unroll
        for (int i = 0; i < 4; ++i) { const int kc = cb + 16 * t + 4 * g + i; if (kc >= cs && kc < cs + 16) vmask |= 1u << (t * 4 + i); dcb[t][i] = min(max(kc - c + 15, 0), 30); }
    const int swz = (cb + cq) & 7;
    for (int p = 0; p < 8; ++p) {
        const int ra = r0 + 2 * p, r = ra + wrow;
        const int hi_next = (p < 7) ? na_rs(ra + 3) + 7 : hi, nnew = hi_next - hi;
        v4u pk0, pv0, pk1, pv1;
        if (nnew >= 1) { pk0 = *(const GAS v4u*)(kvsrc + (size_t)(hi + 1) * 64 * 2560); pv0 = *(const GAS v4u*)(kvsrc + (size_t)(hi + 1) * 64 * 2560 + 768); }
        if (nnew >= 2) { pk1 = *(const GAS v4u*)(kvsrc + (size_t)(hi + 2) * 64 * 2560); pv1 = *(const GAS v4u*)(kvsrc + (size_t)(hi + 2) * 64 * 2560 + 768); }
        {
            const int rsr = na_rs(r);
            int kofs[8], vofs[8], drow[8];
#pragma unroll
            for (int kr = 0; kr < 8; ++kr) { const int R = rsr + kr, slot = R % 9; kofs[kr] = NA_KR + slot * 8192 + cb * 128; vofs[kr] = NA_VR + slot * NA_VSLOT + cb * 2; drow[kr] = (R - r + 7) * 31; }
            bf16* qrow = H0 + (size_t)(b * 2048 + r * 64 + 16 * j + cq) * 2560 + h * 64;
            bf16x8 qf[2]; qf[0] = *(const GAS bf16x8*)(qrow + 8 * g); qf[1] = *(const GAS bf16x8*)(qrow + 32 + 8 * g);
            f32x4 o[4]; float linv;
            attn16<true>(F.lds, kofs, vofs, 136, qf, cq, g, swz, tab, drow, dcb, vmask, o, linv);
            attn_store(qrow, o, linv, g);
        }
        __syncthreads();
        if (nnew >= 1) na_row_write(F, hi + 1, pk0, pv0);
        if (nnew >= 2) na_row_write(F, hi + 2, pk1, pv1);
        hi = hi_next;
        __syncthreads();
    }
}
constexpr int MA_K = 0, MA_V = 32768, MA_VP = 520;
__device__ __forceinline__ void memattn_unit(const Frame& F, bf16* Hq, int ld, int qcol, const bf16* memkv, int b, int h, int tok0, int ntok) {
    const int cq = F.lane & 15, g = F.lane >> 4;
#pragma unroll
    for (int i = 0; i < 4; ++i) {
        const int pce = F.tid + 512 * i, key = pce >> 3, chunk = pce & 7;
        const bf16* src = memkv + (size_t)(b * 256 + key) * 512 + h * 64 + chunk * 8;
        const v4u kv = *(const GAS v4u*)src, vv = *(const GAS v4u*)(src + 256);
        *(LAS v4u*)(F.lds + MA_K + key * 128 + ((chunk ^ (key & 7)) << 4)) = kv;
        LAS unsigned short* vt = (LAS unsigned short*)(F.lds + MA_V) + (chunk * 8) * 260 + key;
        vt[0 * 260] = (unsigned short)(vv.x & 0xffff); vt[1 * 260] = (unsigned short)(vv.x >> 16); vt[2 * 260] = (unsigned short)(vv.y & 0xffff); vt[3 * 260] = (unsigned short)(vv.y >> 16);
        vt[4 * 260] = (unsigned short)(vv.z & 0xffff); vt[5 * 260] = (unsigned short)(vv.z >> 16); vt[6 * 260] = (unsigned short)(vv.w & 0xffff); vt[7 * 260] = (unsigned short)(vv.w >> 16);
    }
    __syncthreads();
    int kofs[8], vofs[8], drow[8]; int dcb[2][4];
#pragma unroll
    for (int kg = 0; kg < 8; ++kg) { kofs[kg] = MA_K + kg * 4096; vofs[kg] = MA_V + kg * 64; drow[kg] = 0; }
#pragma unroll
    for (int t = 0; t < 2; ++t)
#pragma unroll
        for (int i = 0; i < 4; ++i) dcb[t][i] = 0;
    for (int blk = F.wave; blk < ntok / 16; blk += NWAVES) {
        asm volatile("" ::: "memory");
        bf16* qrow = Hq + (size_t)(tok0 + blk * 16 + cq) * ld + qcol + h * 64;
        bf16x8 qf[2]; qf[0] = *(const GAS bf16x8*)(qrow + 8 * g); qf[1] = *(const GAS bf16x8*)(qrow + 32 + 8 * g);
        f32x4 o[4]; float linv;
        attn16<false>(F.lds, kofs, vofs, MA_VP, qf, cq, g, cq & 7, nullptr, drow, dcb, 0u, o, linv);
        attn_store(qrow, o, linv, g);
    }
    __syncthreads();
}
__device__ __forceinline__ void p2_attention(const Frame& F, const Args& a) {
    bf16* H0 = (bf16*)(a.ws + WS_R1); const bf16* memkv = (const bf16*)(a.ws + WS_MEMKV);
    for (int L = blockIdx.x; L < 256; L += gridDim.x) {
        if (L < 192) na_item(F, H0, a.in[8], L / 24, (L % 24) >> 1, L & 1);
        else { const int su = L - 192; memattn_unit(F, H0, 2560, 768, memkv, su >> 3, (su & 7) >> 1, (su >> 3) * 2048 + (su & 1) * 1024, 1024); }
        __syncthreads();
    }
}
constexpr int CW_CNT = 8192;
constexpr size_t RT_TOK = 0, RT_SEL = 1 * MiB, RT_GATES = 2 * MiB;
constexpr int SLOT_ROWS = 36864;

__device__ __forceinline__ float reduce16(float (&a)[16], int lane) {
    const bool b5 = lane & 32, b4 = lane & 16, b3 = lane & 8, b2 = lane & 4;
    float r8[8], r4[4], r2[2];
#pragma unroll
    for (int i = 0; i < 8; ++i) { const float keep = b5 ? a[i + 8] : a[i], send = b5 ? a[i] : a[i + 8]; r8[i] = keep + __shfl_xor(send, 32); }
#pragma unroll
    for (int i = 0; i < 4; ++i) { const float keep = b4 ? r8[i + 4] : r8[i], send = b4 ? r8[i] : r8[i + 4]; r4[i] = keep + __shfl_xor(send, 16); }
#pragma unroll
    for (int i = 0; i < 2; ++i) { const float keep = b3 ? r4[i + 2] : r4[i], send = b3 ? r4[i] : r4[i + 2]; r2[i] = keep + __shfl_xor(send, 8); }
    float r = (b2 ? r2[1] : r2[0]) + __shfl_xor(b2 ? r2[0] : r2[1], 4);
    r += __shfl_xor(r, 2); r += __shfl_xor(r, 1);
    return r;
}
__device__ __forceinline__ void stage_proj16(const Frame& F, const float* W, int ldw, int off) {
    LAS f32x4* dst = (LAS f32x4*)(F.lds + off);
    for (int i = F.tid; i < 1024 * 4; i += NTHREADS) dst[i] = *(const GAS f32x4*)(W + (size_t)(i >> 2) * ldw + (i & 3) * 4);
}
__device__ __forceinline__ float proj16(const Frame& F, const f32x4 (&v)[4], int off) {
    const LAS f32x4* w = (const LAS f32x4*)(F.lds + off);
    float acc[16];
#pragma unroll
    for (int e = 0; e < 16; ++e) acc[e] = 0.f;
#pragma unroll
    for (int j = 0; j < 4; ++j) {
        asm volatile("" ::: "memory");
#pragma unroll
        for (int i = 0; i < 4; ++i) {
            const int c = 4 * F.lane + 256 * j + i; const float xv = v[j][i];
#pragma unroll
            for (int q = 0; q < 4; ++q) { const f32x4 r = w[c * 4 + q]; acc[4 * q] += xv * r.x; acc[4 * q + 1] += xv * r.y; acc[4 * q + 2] += xv * r.z; acc[4 * q + 3] += xv * r.w; }
        }
    }
    return reduce16(acc, F.lane);
}
__device__ __forceinline__ void ln_row(const Frame& F, f32x4 (&v)[4], const float* g, const float* b) {
    float s = 0.f;
#pragma unroll
    for (int j = 0; j < 4; ++j) s += (v[j].x + v[j].y) + (v[j].z + v[j].w);
    const float mean = wave_sum(s) * (1.f / D); float s2 = 0.f;
#pragma unroll
    for (int j = 0; j < 4; ++j) { v[j] = v[j] - mean; s2 += (v[j].x * v[j].x + v[j].y * v[j].y) + (v[j].z * v[j].z + v[j].w * v[j].w); }
    const float rstd = 1.f / sqrtf(wave_sum(s2) * (1.f / D) + LN_EPS);
#pragma unroll
    for (int j = 0; j < 4; ++j) { const f32x4 gg = ((const GAS f32x4*)g)[F.lane + 64 * j], bb = ((const GAS f32x4*)b)[F.lane + 64 * j]; v[j] = v[j] * rstd * gg + bb; }
}
__device__ __forceinline__ void store_row_f32_bf16(const Frame& F, const f32x4 (&v)[4], float* xo, bf16* xb) {
#pragma unroll
    for (int j = 0; j < 4; ++j) { ((GAS f32x4*)xo)[F.lane + 64 * j] = v[j];
        ((GAS unsigned long long*)xb)[F.lane + 64 * j] = (unsigned long long)pk2(v[j].x, v[j].y) | ((unsigned long long)pk2(v[j].z, v[j].w) << 32); }
}
__device__ __forceinline__ f32x4 bf4_to_f32(unsigned long long w) { return (f32x4){bflo((unsigned)w), bfhi((unsigned)w), bflo((unsigned)(w >> 32)), bfhi((unsigned)(w >> 32))}; }

constexpr int P4_W = 0, P4_LG = 65536;
__device__ __forceinline__ void p4_ln_route(const Frame& F, const Args& a, int layer, const float* xres, float* xout) {
    unsigned char* ws = a.ws;
    const bf16* T = (const bf16*)(ws + WS_R3); bf16* XBF = (bf16*)(ws + WS_XBF);
    const float* g = a.in[17] + (layer * 2) * 1024; const float* bb = a.in[18] + (layer * 2) * 1024;
    int* tokmap = (int*)(ws + WS_ROUTE + RT_TOK); int* sel = (int*)(ws + WS_ROUTE + RT_SEL);
    gu32* cnt = F.ctl + CW_CNT + 64 * layer;
    stage_proj16(F, a.in[5], 16, P4_W);
    __syncthreads();
    LAS float* lg = (LAS float*)(F.lds + P4_LG);
    for (int grp = blockIdx.x; grp < NTOK / 64; grp += gridDim.x) {
        for (int tt = 0; tt < 8; ++tt) {
            const int slot = F.wave * 8 + tt, t = grp * 64 + slot;
            f32x4 v[4];
#pragma unroll
            for (int j = 0; j < 4; ++j) { const f32x4 xr = ((const GAS f32x4*)(xres + (size_t)t * D))[F.lane + 64 * j];
                const f32x4 tv = bf4_to_f32(((const GAS unsigned long long*)(T + (size_t)t * D))[F.lane + 64 * j]); v[j] = xr * ALPHA + tv; }
            ln_row(F, v, g, bb);
            store_row_f32_bf16(F, v, xout + (size_t)t * D, XBF + (size_t)t * D);
            const float lgt = proj16(F, v, P4_W);
            if ((F.lane & 3) == 0) lg[slot * 16 + (F.lane >> 2)] = lgt;
        }
        __syncthreads();
        if (F.wave == 0) {
            const int t = grp * 64 + F.lane;
            const float* rb = a.in[6];
            float bestg = -1e30f; int bi1 = 0, bi2 = 1; float bs1 = 0.f, bs2 = 0.f;
#pragma unroll
            for (int gq = 0; gq < 4; ++gq) {
                const f32x4 l4 = *(const LAS f32x4*)(lg + F.lane * 16 + gq * 4);
                float v1 = -1e30f, v2 = -1e30f, s1 = 0.f, s2 = 0.f; int i1 = 0, i2 = 0;
#pragma unroll
                for (int j = 0; j < 4; ++j) {
                    const int e = gq * 4 + j; const float sc = 1.f / (1.f + expf(-l4[j])); const float bv = sc + rb[e];
                    if (bv > v1) { v2 = v1; i2 = i1; s2 = s1; v1 = bv; i1 = e; s1 = sc; } else if (bv > v2) { v2 = bv; i2 = e; s2 = sc; }
                }
                const float gs = v1 + v2;
                if (gs > bestg) { bestg = gs; bi1 = i1; bi2 = i2; bs1 = s1; bs2 = s2; }
            }
            const float inv = 1.f / (bs1 + bs2);
            unsigned mycnt = 0u; int p1 = 0, p2 = 0;
#pragma unroll
            for (int e = 0; e < 16; ++e) {
                const unsigned long long mk_ = __ballot(bi1 == e || bi2 == e); const unsigned c = (unsigned)__popcll(mk_);
                if (F.lane == e) mycnt = c;
                const int pre = __popcll(mk_ & ((1ull << F.lane) - 1ull));
                if (bi1 == e) p1 = pre; if (bi2 == e) p2 = pre;
            }
            unsigned base = 0u;
            if (F.lane < 16 && mycnt) base = __hip_atomic_fetch_add(cnt + F.lane, mycnt, RLX_AGENT);
            p1 += (int)__shfl(base, bi1); p2 += (int)__shfl(base, bi2);
            tokmap[bi1 * NTOK + p1] = t; tokmap[bi2 * NTOK + p2] = t;
            GAS int* s8 = (GAS int*)(sel + (size_t)t * 8);
            *(GAS v4u*)s8 = (v4u){(unsigned)bi1, (unsigned)p1, (unsigned)bi2, (unsigned)p2};
            *(GAS v2u*)(s8 + 4) = (v2u){__builtin_bit_cast(unsigned, bs1 * inv), __builtin_bit_cast(unsigned, bs2 * inv)};
        }
        __syncthreads();
    }
}
__device__ __forceinline__ void slot_offsets(const Frame& F, int layer) {
    __syncthreads();
    if (F.tid == 0) { gu32* cnt = F.ctl + CW_CNT + 64 * layer; int o = 0;
        for (int e = 0; e < 16; ++e) { const int c = (int)__hip_atomic_load(cnt + e, RLX_AGENT); F.MISC[32 + e] = (unsigned)c; F.MISC[16 + e] = (unsigned)o; o += ((c + 255) >> 8) << 8; } }
    __syncthreads();
}
__device__ __forceinline__ int slot_off(const Frame& F, int e) { return (int)F.MISC[16 + e]; }
__device__ __forceinline__ int slot_cnt(const Frame& F, int e) { return (int)F.MISC[32 + e]; }
__device__ __forceinline__ void p4b_scatter(const Frame& F, const Args& a, int layer) {
    unsigned char* ws = a.ws; const bf16* XBF = (const bf16*)(ws + WS_XBF); bf16* XG = (bf16*)(ws + WS_R3); const int* sel = (const int*)(ws + WS_ROUTE + RT_SEL);
    slot_offsets(F, layer);
    const int gw = blockIdx.x * NWAVES + F.wave, NGW = gridDim.x * NWAVES;
    for (int t = gw; t < NTOK; t += NGW) {
        const v4u s = *(const GAS v4u*)(sel + (size_t)t * 8);
        const int s0 = slot_off(F, (int)s.x) + (int)s.y, s1 = slot_off(F, (int)s.z) + (int)s.w;
        const GAS v4u* src = (const GAS v4u*)(XBF + (size_t)t * D) + F.lane; const v4u r0 = src[0], r1 = src[64];
        GAS v4u* d0 = (GAS v4u*)(XG + (size_t)s0 * D) + F.lane; GAS v4u* d1 = (GAS v4u*)(XG + (size_t)s1 * D) + F.lane;
        d0[0] = r0; d0[64] = r1; d1[0] = r0; d1[64] = r1;
    }
}
__device__ __forceinline__ void p7_combine_ln(const Frame& F, const Args& a, int layer, float* xio) {
    unsigned char* ws = a.ws; const bf16* Y = (const bf16*)(ws + WS_R3); bf16* XBF = (bf16*)(ws + WS_XBF); const int* sel = (const int*)(ws + WS_ROUTE + RT_SEL);
    float* gates = (float*)(ws + WS_ROUTE + RT_GATES);
    const float* g = a.in[17] + (layer * 2 + 1) * 1024; const float* bb = a.in[18] + (layer * 2 + 1) * 1024;
    slot_offsets(F, layer);
    if (layer == 0) { stage_proj16(F, a.in[9] + 1536, 1808, P4_W); __syncthreads(); }
    const int gw = blockIdx.x * NWAVES + F.wave, NGW = gridDim.x * NWAVES;
#pragma unroll 1
    for (int t = gw; t < NTOK; t += NGW) {
        const v4u s = *(const GAS v4u*)(sel + (size_t)t * 8); const f32x2_t wf = *(const GAS f32x2_t*)(sel + (size_t)t * 8 + 4);
        const float w0 = wf.x, w1 = wf.y;
        const int s0 = slot_off(F, (int)s.x) + (int)s.y, s1 = slot_off(F, (int)s.z) + (int)s.w;
        f32x4 v[4];
#pragma unroll
        for (int j = 0; j < 4; ++j) { const f32x4 xr = ((const GAS f32x4*)(xio + (size_t)t * D))[F.lane + 64 * j];
            const f32x4 y0 = bf4_to_f32(((const GAS unsigned long long*)(Y + (size_t)s0 * D))[F.lane + 64 * j]), y1 = bf4_to_f32(((const GAS unsigned long long*)(Y + (size_t)s1 * D))[F.lane + 64 * j]);
            v[j] = xr * ALPHA + y0 * w0 + y1 * w1; }
        ln_row(F, v, g, bb);
        store_row_f32_bf16(F, v, xio + (size_t)t * D, XBF + (size_t)t * D);
        if (layer == 0) { const float gt = proj16(F, v, P4_W); if ((F.lane & 3) == 0) gates[(size_t)t * 16 + (F.lane >> 2)] = gt + a.in[13][F.lane >> 2]; }
    }
}
struct MoeSched {
    const char* A; const char* B; size_t tA, tB, eB;
    int x, local, nloc;
    int nb0, nb1, rb0, rb1;
    __device__ __forceinline__ bool next(int i, pg8::Unit& u) const {
        const int q = i * nloc + local; if (q >= 4 * (nb0 + nb1)) return false;
        if (q < 4 * nb0) { u.g = x; u.pm = rb0 + (q >> 2); u.pn = q & 3; } else { const int q1 = q - 4 * nb0; u.g = x + 8; u.pm = rb1 + (q1 >> 2); u.pn = q1 & 3; }
        return true;
    }
    __device__ __forceinline__ const char* a_ptr(const pg8::Unit& u) const { return A + (size_t)u.pm * tA; }
    __device__ __forceinline__ const char* b_ptr(const pg8::Unit& u) const { return B + (size_t)u.g * eB + (size_t)u.pn * tB; }
    __device__ __forceinline__ void a_ready(const pg8::Unit&) const {}
    __device__ __forceinline__ void done(const pg8::Unit&) const {}
};
__device__ __forceinline__ MoeSched make_moe_sched(const Frame& F, int layer, const char* A, size_t tA, const char* B, size_t tB, size_t eB) {
    slot_offsets(F, layer);
    MoeSched S; S.A = A; S.B = B; S.tA = tA; S.tB = tB; S.eB = eB;
    S.x = blockIdx.x & 7; S.local = blockIdx.x >> 3; S.nloc = gridDim.x >> 3;
    S.nb0 = (slot_cnt(F, S.x) + 255) >> 8; S.nb1 = (slot_cnt(F, S.x + 8) + 255) >> 8; S.rb0 = slot_off(F, S.x) >> 8; S.rb1 = slot_off(F, S.x + 8) >> 8;
    return S;
}
struct EpiSwiGLU {
    static constexpr bool PERM = true, AFTER_DRAIN = false;
    pg8::bf16_t* HM;
    __device__ __forceinline__ void operator()(const pg8::f32x4 (&acc)[2][2][4][2], const pg8::Unit& u, int wr, int wc, int fr, int fq) const {
        const int row0 = u.pm * 256 + wr * 64 + fr, col0 = u.pn * 128 + wc * 32 + 8 * fq;
#pragma unroll
        for (int ai = 0; ai < 2; ++ai)
#pragma unroll
            for (int m = 0; m < 4; ++m) {
                float hv[8];
#pragma unroll
                for (int n = 0; n < 2; ++n)
#pragma unroll
                    for (int i = 0; i < 4; ++i) { const float gt = acc[ai][0][m][n][i], up = acc[ai][1][m][n][i]; hv[4 * n + i] = gt / (1.f + __expf(-gt)) * up; }
                pg8::u32x4 w; w.x = pg8::cvt_pk_bf16(hv[0], hv[1]); w.y = pg8::cvt_pk_bf16(hv[2], hv[3]); w.z = pg8::cvt_pk_bf16(hv[4], hv[5]); w.w = pg8::cvt_pk_bf16(hv[6], hv[7]);
                *(pg8::u32x4*)(HM + (size_t)(row0 + ai * 128 + m * 16) * 512 + col0) = w;
            }
    }
};
struct EpiStoreOne {
    static constexpr bool PERM = true, AFTER_DRAIN = false;
    pg8::bf16_t* O; int ldc;
    __device__ __forceinline__ void operator()(const pg8::f32x4 (&acc)[2][2][4][2], const pg8::Unit& u, int wr, int wc, int fr, int fq) const {
        const int row0 = u.pm * 256 + wr * 64 + fr, col0 = u.pn * 256 + wc * 32 + 8 * fq;
#pragma unroll
        for (int ai = 0; ai < 2; ++ai)
#pragma unroll
            for (int m = 0; m < 4; ++m) { pg8::bf16_t* rowp = O + (size_t)(row0 + ai * 128 + m * 16) * ldc + col0;
#pragma unroll
                for (int bj = 0; bj < 2; ++bj) { const pg8::f32x4 v0 = acc[ai][bj][m][0], v1 = acc[ai][bj][m][1];
                    pg8::u32x4 w; w.x = pg8::cvt_pk_bf16(v0[0], v0[1]); w.y = pg8::cvt_pk_bf16(v0[2], v0[3]); w.z = pg8::cvt_pk_bf16(v1[0], v1[1]); w.w = pg8::cvt_pk_bf16(v1[2], v1[3]);
                    *(pg8::u32x4*)(rowp + bj * 128) = w; } }
    }
};
constexpr size_t WS_HM = WS_R1;
__device__ __forceinline__ void p5_moe_up(const Frame& F, const Args& a, int layer) {
    unsigned char* ws = a.ws;
    pg8::Gemm g{1024, 1024, 1024};
    const MoeSched S = make_moe_sched(F, layer, (const char*)(ws + WS_R3), (size_t)256 * 1024 * 2, (const char*)(ws + WS_WEXP), (size_t)256 * 1024 * 2, (size_t)1024 * 1024 * 2);
    EpiSwiGLU E{(pg8::bf16_t*)(ws + WS_HM)};
    pg8::gemm_phase<EpiSwiGLU, MoeSched, true, true>(F.lds, g, S, E);
}
__device__ __forceinline__ void p6_moe_down(const Frame& F, const Args& a, int layer) {
    unsigned char* ws = a.ws;
    pg8::Gemm g{512, 512, 512};
    const MoeSched S = make_moe_sched(F, layer, (const char*)(ws + WS_HM), (size_t)256 * 512 * 2, (const char*)(ws + WS_WEXP + 32 * MiB), (size_t)256 * 512 * 2, (size_t)1024 * 512 * 2);
    EpiStoreOne E{(pg8::bf16_t*)(ws + WS_R3), 1024};
    pg8::gemm_phase<EpiStoreOne, MoeSched, true, true>(F.lds, g, S, E);
}
constexpr size_t WS_H1 = WS_R1;
constexpr size_t WS_XC = WS_R1 + (size_t)16384 * 1792 * 2;
constexpr size_t WS_Q = WS_R3, WS_K = WS_R3 + (size_t)16384 * 768 * 2, WS_VT = WS_R3 + (size_t)2 * 16384 * 768 * 2;
constexpr size_t WS_KT = WS_WEXP + 24 * MiB;
constexpr int CQ_P = 400, CQ_XM = 0, CQ_XC = 68 * CQ_P, CQ_W = CQ_XC + 64 * CQ_P;
static_assert(CQ_W + 192 * CQ_P <= LDSCTL_OFF, "conv/qkv LDS map");

__device__ __forceinline__ void cq_stage_w(const Frame& F, const bf16* W  ) {
    for (int i = F.tid; i < 192 * 24; i += NTHREADS) { const int r = i / 24, c = i % 24; *(LAS v4u*)(F.lds + CQ_W + r * CQ_P + c * 16) = *(const GAS v4u*)(W + r * 192 + c * 8); }
}
template <bool TRANS>
__device__ __forceinline__ void cq_gemm(const Frame& F, int xoff  , f32x4 (&acc)[6]) {
    const int cq = F.lane & 15, g = F.lane >> 4, wr = F.wave & 3, wc = F.wave >> 2;
    bf16x8 xf[6];
#pragma unroll
    for (int ks = 0; ks < 6; ++ks) xf[ks] = *(const LAS bf16x8*)(F.lds + xoff + (16 * wr + cq) * CQ_P + (32 * ks + 8 * g) * 2);
#pragma unroll
    for (int nt = 0; nt < 6; ++nt) {
        f32x4 a = {0.f, 0.f, 0.f, 0.f};
#pragma unroll
        for (int ks = 0; ks < 6; ++ks) {
            const bf16x8 wf = *(const LAS bf16x8*)(F.lds + CQ_W + (96 * wc + 16 * nt + cq) * CQ_P + (32 * ks + 8 * g) * 2);
            a = TRANS ? MFMA16(wf, xf[ks], a) : MFMA16(xf[ks], wf, a);
        }
        acc[nt] = a;
    }
}
__device__ __forceinline__ void p10_convqkv(const Frame& F, const Args& a) {
    unsigned char* ws = a.ws;
    const bf16* H1 = (const bf16*)(ws + WS_H1); bf16* XCg = (bf16*)(ws + WS_XC); bf16* Qg = (bf16*)(ws + WS_Q); bf16* Kg = (bf16*)(ws + WS_K); bf16* VTg = (bf16*)(ws + WS_VT); bf16* KTg = (bf16*)(ws + WS_KT);
    const bf16* WQKV = (const bf16*)(ws + WS_WQKV); const float* cw = a.in[10]; const float* cbias = a.in[11];
    const int cq = F.lane & 15, g = F.lane >> 4, wr = F.wave & 3, wc = F.wave >> 2;
    for (int u = blockIdx.x; u < 1024; u += gridDim.x) {
        const int h = u & 3, tile = u >> 2, t0 = tile * 64, b = t0 >> 11, s0 = t0 & 2047, bh = b * 4 + h;
        for (int i = F.tid; i < 68 * 24; i += NTHREADS) { const int r = i / 24, c = i % 24, s = s0 - 2 + r; v4u v = {0u, 0u, 0u, 0u};
            if (s >= 0 && s < 2048) v = *(const GAS v4u*)(H1 + (size_t)(b * 2048 + s) * 1792 + h * 192 + c * 8);
            *(LAS v4u*)(F.lds + CQ_XM + r * CQ_P + c * 16) = v; }
        cq_stage_w(F, WQKV + (size_t)(0 * 4 + h) * 192 * 192);
        __syncthreads();
        if (F.tid < 384) {
            const int c = F.tid % 192, half = F.tid / 192, ch = h * 192 + c;
            const float w0 = cw[0 * 768 + ch], w1 = cw[1 * 768 + ch], w2 = cw[2 * 768 + ch], w3 = cw[3 * 768 + ch], w4 = cw[4 * 768 + ch], bs = cbias[ch];
            const LAS unsigned short* xm = (const LAS unsigned short*)(F.lds + CQ_XM) + c; LAS unsigned short* xc = (LAS unsigned short*)(F.lds + CQ_XC) + c;
            float x0 = bf2f(xm[(32 * half + 0) * 200]), x1 = bf2f(xm[(32 * half + 1) * 200]), x2 = bf2f(xm[(32 * half + 2) * 200]), x3 = bf2f(xm[(32 * half + 3) * 200]);
            for (int r = 32 * half; r < 32 * half + 32; ++r) {
                const float x4 = bf2f(xm[(r + 4) * 200]);
                const float y = bs + x0 * w0 + x1 * w1 + x2 * w2 + x3 * w3 + x4 * w4;
                const unsigned short o = (unsigned short)f2bf(y / (1.f + __expf(-y)));
                xc[r * 200] = o; XCg[(size_t)(t0 + r) * 768 + ch] = o;
                x0 = x1; x1 = x2; x2 = x3; x3 = x4;
            }
        }
        __syncthreads();
        f32x4 acc[6];
        cq_gemm<true>(F, CQ_XC, acc);
        { bf16* dst = Qg + ((size_t)bh * 2048 + s0 + 16 * wr + cq) * 192 + 96 * wc + 4 * g;
#pragma unroll
          for (int nt = 0; nt < 6; ++nt) { v2u w; w.x = cvtpk(acc[nt][0], acc[nt][1]); w.y = cvtpk(acc[nt][2], acc[nt][3]); *(GAS v2u*)(dst + 16 * nt) = w; } }
        __syncthreads();
        cq_stage_w(F, WQKV + (size_t)(1 * 4 + h) * 192 * 192);
        __syncthreads();
        cq_gemm<true>(F, CQ_XC, acc);
        { bf16* dst = Kg + ((size_t)bh * 2048 + s0 + 16 * wr + cq) * 192 + 96 * wc + 4 * g;
#pragma unroll
          for (int nt = 0; nt < 6; ++nt) { v2u w; w.x = cvtpk(acc[nt][0], acc[nt][1]); w.y = cvtpk(acc[nt][2], acc[nt][3]); *(GAS v2u*)(dst + 16 * nt) = w; } }
        cq_gemm<false>(F, CQ_XC, acc);
        { bf16* dst = KTg + ((size_t)bh * 192 + 96 * wc + cq) * 2048 + s0 + 16 * wr + 4 * g;
#pragma unroll
          for (int nt = 0; nt < 6; ++nt) { v2u w; w.x = cvtpk(acc[nt][0], acc[nt][1]); w.y = cvtpk(acc[nt][2], acc[nt][3]); *(GAS v2u*)(dst + (size_t)16 * nt * 2048) = w; } }
        __syncthreads();
        cq_stage_w(F, WQKV + (size_t)(2 * 4 + h) * 192 * 192);
        __syncthreads();
        cq_gemm<false>(F, CQ_XM + 2 * CQ_P, acc);
        { bf16* dst = VTg + ((size_t)bh * 192 + 96 * wc + cq) * 2048 + s0 + 16 * wr + 4 * g;
#pragma unroll
          for (int nt = 0; nt < 6; ++nt) { v2u w; w.x = cvtpk(acc[nt][0], acc[nt][1]); w.y = cvtpk(acc[nt][2], acc[nt][3]); *(GAS v2u*)(dst + (size_t)16 * nt * 2048) = w; } }
        __syncthreads();
    }
}
constexpr size_t WS_HF = WS_XBF, WS_HB = WS_WEXP;
constexpr int ML_Q = 0, ML_K = 25600, ML_KT = 51200, ML_VT = 75776, ML_VW = 84480, ML_CT = 92672, ML_N = 118272, ML_G = 119040, ML_DW = ML_G + 1536;
static_assert(ML_DW + 512 <= LDSCTL_OFF, "mLSTM LDS map");
struct MlPre { v4u q[3], k[3], kt[3], vt; };
__device__ __forceinline__ void ml_issue(const Frame& F, MlPre& P, const bf16* Qb, const bf16* Kb, const bf16* KTb, const bf16* VTb, int sb) {
    int tid = F.tid; asm volatile("" : "+v"(tid));
#pragma unroll
    for (int i = 0; i < 3; ++i) { const int pc = tid + 512 * i, r = pc / 24, c = pc % 24;
        P.q[i] = *(const GAS v4u*)(Qb + (size_t)(sb + r) * 192 + c * 8); P.k[i] = *(const GAS v4u*)(Kb + (size_t)(sb + r) * 192 + c * 8);
        const int d = pc >> 3, c8 = pc & 7; P.kt[i] = *(const GAS v4u*)(KTb + (size_t)d * 2048 + sb + c8 * 8); }
    { const int e = tid >> 3, c8 = tid & 7; P.vt = *(const GAS v4u*)(VTb + (size_t)e * 2048 + sb + c8 * 8); }
}
__device__ __forceinline__ void ml_commit(const Frame& F, const MlPre& P) {
    int tid = F.tid; asm volatile("" : "+v"(tid));
#pragma unroll
    for (int i = 0; i < 3; ++i) { const int pc = tid + 512 * i, r = pc / 24, c = pc % 24;
        *(LAS v4u*)(F.lds + ML_Q + r * 400 + c * 16) = P.q[i]; *(LAS v4u*)(F.lds + ML_K + r * 400 + c * 16) = P.k[i];
        const int d = pc >> 3, c8 = pc & 7; *(LAS v4u*)(F.lds + ML_KT + d * 128 + ((c8 ^ (d & 7)) << 4)) = P.kt[i]; }
    { const int e = tid >> 3, c8 = tid & 7; LAS v2u* dst = (LAS v2u*)(F.lds + ML_VT + e * 136 + c8 * 16); dst[0] = (v2u){P.vt.x, P.vt.y}; dst[1] = (v2u){P.vt.z, P.vt.w}; }
}
__device__ __forceinline__ void mlstm_item(const Frame& F, const Args& a, int b, int h, int dir, int es) {
    unsigned char* ws = a.ws;
    const int bh = b * 4 + h, cq0 = F.lane & 15, g0 = F.lane >> 4, tt = F.wave & 3, eh = F.wave >> 2;
    const bf16* Qb = (const bf16*)(ws + WS_Q) + (size_t)bh * 2048 * 192; const bf16* Kb = (const bf16*)(ws + WS_K) + (size_t)bh * 2048 * 192;
    const bf16* KTb = (const bf16*)(ws + WS_KT) + (size_t)bh * 192 * 2048; const bf16* VTb = (const bf16*)(ws + WS_VT) + ((size_t)bh * 192 + 64 * es) * 2048;
    const float* G = (const float*)(ws + WS_ROUTE + RT_GATES) + (size_t)b * 2048 * 16;
    bf16* Hout = (bf16*)(ws + (dir ? WS_HB : WS_HF)) + (size_t)b * 2048 * 768 + h * 192 + 64 * es;
    LAS float* gcum = (LAS float*)(F.lds + ML_G); LAS float* ga = gcum + 64; LAS float* gdec = gcum + 128; LAS float* gw = gcum + 192; LAS float* gsc = gcum + 256;
    LAS float* nvec = (LAS float*)(F.lds + ML_N); LAS float* denw = (LAS float*)(F.lds + ML_DW) + F.wave * 16;
    for (int i = F.tid; i < 64 * 100; i += NTHREADS) ((LAS unsigned*)(F.lds + ML_CT))[i] = 0u;
    if (F.tid < 192) nvec[F.tid] = 0.f;
    f32x4 cacc[6];
#pragma unroll
    for (int i = 0; i < 6; ++i) cacc[i] = (f32x4){0.f, 0.f, 0.f, 0.f};
    MlPre P;
    { const int c0 = dir ? 31 : 0; ml_issue(F, P, Qb, Kb, KTb, VTb, 64 * c0); ml_commit(F, P); }
    for (int ci = 0; ci < 32; ++ci) {
        const int c = dir ? 31 - ci : ci, sb = 64 * c;
        int cq = cq0, g = g0; asm volatile("" : "+v"(cq), "+v"(g));
        if (F.wave == 0) {
            const float* gp = G + (size_t)(sb + F.lane) * 16 + dir * 8 + h;
            const float ig = gp[0], fg = gp[4];
            float lf = fminf(fg, 0.f) - log1pf(__expf(-fabsf(fg)));
            float cum = lf;
#pragma unroll
            for (int o = 1; o < 64; o <<= 1) { const float v = dir ? __shfl_down(cum, o) : __shfl_up(cum, o); const bool ok = dir ? (F.lane + o < 64) : (F.lane >= o); cum += ok ? v : 0.f; }
            const float total = __shfl(cum, dir ? 0 : 63);
            gcum[F.lane] = cum; ga[F.lane] = ig - cum; gdec[F.lane] = __expf(cum); gw[F.lane] = __expf(total - cum + ig);
            if (F.lane == 0) gsc[0] = __expf(total);
        }
        if (ci < 31) ml_issue(F, P, Qb, Kb, KTb, VTb, 64 * (dir ? c - 1 : c + 1));
        __syncthreads();
        { const int e = F.tid >> 3, c8 = F.tid & 7; const LAS v2u* src = (const LAS v2u*)(F.lds + ML_VT + e * 136 + c8 * 16); const v2u lo = src[0], hi = src[1];
          const f32x4 w0 = *(const LAS f32x4*)(gw + 8 * c8), w1 = *(const LAS f32x4*)(gw + 8 * c8 + 4);
          v4u o; o.x = cvtpk(bflo(lo.x) * w0.x, bfhi(lo.x) * w0.y); o.y = cvtpk(bflo(lo.y) * w0.z, bfhi(lo.y) * w0.w); o.z = cvtpk(bflo(hi.x) * w1.x, bfhi(hi.x) * w1.y); o.w = cvtpk(bflo(hi.y) * w1.z, bfhi(hi.y) * w1.w);
          *(LAS v4u*)(F.lds + ML_VW + e * 128 + ((c8 ^ (e & 7)) << 4)) = o; }
        bf16x8 qf[6];
#pragma unroll
        for (int ks = 0; ks < 6; ++ks) qf[ks] = *(const LAS bf16x8*)(F.lds + ML_Q + (16 * tt + cq) * 400 + (32 * ks + 8 * g) * 2);
        f32x4 sacc[4];
#pragma unroll
        for (int st = 0; st < 4; ++st) { f32x4 z = {0.f, 0.f, 0.f, 0.f};
#pragma unroll
            for (int ks = 0; ks < 6; ++ks) { const bf16x8 kf = *(const LAS bf16x8*)(F.lds + ML_K + (16 * st + cq) * 400 + (32 * ks + 8 * g) * 2); z = MFMA16(kf, qf[ks], z); }
            sacc[st] = z; __builtin_amdgcn_sched_barrier(0); }
        const int tl = 16 * tt + cq; const float cum_t = gcum[tl], dec_t = gdec[tl];
        float dpart = 0.f;
#pragma unroll
        for (int st = 0; st < 4; ++st) { const f32x4 a4 = *(const LAS f32x4*)(ga + 16 * st + 4 * g);
#pragma unroll
            for (int i = 0; i < 4; ++i) { const int sl = 16 * st + 4 * g + i; const bool ok = dir ? (sl >= tl) : (sl <= tl);
                const float p = ok ? sacc[st][i] * __expf(cum_t + a4[i]) : 0.f; sacc[st][i] = p; dpart += p; } }
        dpart += __shfl_xor(dpart, 16); dpart += __shfl_xor(dpart, 32);
        __builtin_amdgcn_sched_barrier(0);
        float qn = 0.f;
#pragma unroll
        for (int ks = 0; ks < 6; ++ks) { const f32x4 n0 = *(const LAS f32x4*)(nvec + 32 * ks + 8 * g), n1 = *(const LAS f32x4*)(nvec + 32 * ks + 8 * g + 4); const v4u qw = __builtin_bit_cast(v4u, qf[ks]);
            qn += bflo(qw.x) * n0.x + bfhi(qw.x) * n0.y + bflo(qw.y) * n0.z + bfhi(qw.y) * n0.w + bflo(qw.z) * n1.x + bfhi(qw.z) * n1.y + bflo(qw.w) * n1.z + bfhi(qw.w) * n1.w; }
        qn += __shfl_xor(qn, 16); qn += __shfl_xor(qn, 32);
        if (g == 0) denw[cq] = dpart + dec_t * qn;
        __builtin_amdgcn_sched_barrier(0);
        f32x4 o[2];
#pragma unroll
        for (int nt = 0; nt < 2; ++nt) { f32x4 z = {0.f, 0.f, 0.f, 0.f};
#pragma unroll
            for (int ks = 0; ks < 6; ++ks) { const bf16x8 cf = *(const LAS bf16x8*)(F.lds + ML_CT + (32 * eh + 16 * nt + cq) * 400 + (32 * ks + 8 * g) * 2); z = MFMA16(qf[ks], cf, z); }
            o[nt] = z; __builtin_amdgcn_sched_barrier(0); }
        { const f32x4 d4 = *(const LAS f32x4*)(gdec + 16 * tt + 4 * g);
#pragma unroll
          for (int nt = 0; nt < 2; ++nt) o[nt] = o[nt] * d4; }
#pragma unroll
        for (int kk = 0; kk < 2; ++kk) {
            v4u pw; pw.x = cvtpk(sacc[2 * kk][0], sacc[2 * kk][1]); pw.y = cvtpk(sacc[2 * kk][2], sacc[2 * kk][3]); pw.z = cvtpk(sacc[2 * kk + 1][0], sacc[2 * kk + 1][1]); pw.w = cvtpk(sacc[2 * kk + 1][2], sacc[2 * kk + 1][3]);
            const bf16x8 pf = __builtin_bit_cast(bf16x8, pw);
#pragma unroll
            for (int nt = 0; nt < 2; ++nt) { const int va = ML_VT + (32 * eh + 16 * nt + cq) * 136 + (32 * kk + 4 * g) * 2;
                const s16x4 lo = *(const LAS s16x4*)(F.lds + va), hi = *(const LAS s16x4*)(F.lds + va + 32);
                o[nt] = MFMA16(pf, __builtin_shufflevector(lo, hi, 0, 1, 2, 3, 4, 5, 6, 7), o[nt]); }
        }
        __builtin_amdgcn_sched_barrier(0);
        { const f32x4 dn = *(const LAS f32x4*)(denw + 4 * g);
#pragma unroll
          for (int i = 0; i < 4; ++i) { const float inv = 1.f / fmaxf(fabsf(dn[i]), 1.f); bf16* hp = Hout + (size_t)(sb + 16 * tt + 4 * g + i) * 768 + 32 * eh + cq;
              hp[0] = (bf16)f2bf(o[0][i] * inv); hp[16] = (bf16)f2bf(o[1][i] * inv); } }
        __syncthreads();
        { const int nt4 = F.wave & 3, dh = F.wave >> 2; const float cdec = gsc[0];
          bf16x8 vf[2];
#pragma unroll
          for (int kk = 0; kk < 2; ++kk) { const int er = 16 * nt4 + cq; vf[kk] = *(const LAS bf16x8*)(F.lds + ML_VW + er * 128 + (((4 * kk + g) ^ (er & 7)) << 4)); }
#pragma unroll
          for (int j = 0; j < 6; ++j) { const int dr = 96 * dh + 16 * j + cq; f32x4 z = cacc[j] * cdec;
#pragma unroll
              for (int kk = 0; kk < 2; ++kk) { const bf16x8 kf = *(const LAS bf16x8*)(F.lds + ML_KT + dr * 128 + (((4 * kk + g) ^ (dr & 7)) << 4)); z = MFMA16(kf, vf[kk], z); }
              cacc[j] = z; __builtin_amdgcn_sched_barrier(0); } }
        float nnew = 0.f;
        if (F.tid < 192) { const int d = F.tid; float acc = gsc[0] * nvec[d];
#pragma unroll
            for (int c8 = 0; c8 < 8; ++c8) { const v4u kw = *(const LAS v4u*)(F.lds + ML_KT + d * 128 + ((c8 ^ (d & 7)) << 4)); const f32x4 w0 = *(const LAS f32x4*)(gw + 8 * c8), w1 = *(const LAS f32x4*)(gw + 8 * c8 + 4);
                acc += bflo(kw.x) * w0.x + bfhi(kw.x) * w0.y + bflo(kw.y) * w0.z + bfhi(kw.y) * w0.w + bflo(kw.z) * w1.x + bfhi(kw.z) * w1.y + bflo(kw.w) * w1.z + bfhi(kw.w) * w1.w; }
            nnew = acc; }
        __syncthreads();
        { const int nt4 = F.wave & 3, dh = F.wave >> 2;
#pragma unroll
          for (int j = 0; j < 6; ++j) { v2u w; w.x = cvtpk(cacc[j][0], cacc[j][1]); w.y = cvtpk(cacc[j][2], cacc[j][3]); *(LAS v2u*)(F.lds + ML_CT + (16 * nt4 + cq) * 400 + (96 * dh + 16 * j + 4 * g) * 2) = w; } }
        if (F.tid < 192) nvec[F.tid] = nnew;
        if (ci < 31) ml_commit(F, P);
    }
    __syncthreads();
}
__device__ __forceinline__ void p11_mlstm(const Frame& F, const Args& a) {
    bf16* H1 = (bf16*)(a.ws + WS_H1); const bf16* memkv = (const bf16*)(a.ws + WS_MEMKV);
    for (int L = blockIdx.x; L < 256; L += gridDim.x) {
        if (L < 192) { const int es = L % 3, r = L / 3; mlstm_item(F, a, r >> 3, (r >> 1) & 3, r & 1, es); }
        else { const int su = L - 192; memattn_unit(F, H1, 1792, 768, memkv, su >> 3, (su & 7) >> 1, (su >> 3) * 2048 + (su & 1) * 1024, 1024); }
        __syncthreads();
    }
}
__device__ __forceinline__ void p12_mlstm_out(const Frame& F, const Args& a) {
    unsigned char* ws = a.ws; bf16* H1 = (bf16*)(ws + WS_H1); const bf16* XC = (const bf16*)(ws + WS_XC); const bf16* HF = (const bf16*)(ws + WS_HF); const bf16* HB = (const bf16*)(ws + WS_HB);
    const float* ng = a.in[14]; const float* sk = a.in[15];
    const int gw = blockIdx.x * NWAVES + F.wave, NGW = gridDim.x * NWAVES;
    for (int it = gw; it < NTOK * 4; it += NGW) {
        const int t = it >> 2, h = it & 3;
        float x[3]; float sm = 0.f;
#pragma unroll
        for (int j = 0; j < 3; ++j) { const size_t i = (size_t)t * 768 + h * 192 + F.lane + 64 * j; x[j] = bf2f(HF[i]) + bf2f(HB[i]); sm += x[j]; }
        const float mean = wave_sum(sm) * (1.f / 192.f); float qv = 0.f;
#pragma unroll
        for (int j = 0; j < 3; ++j) { x[j] -= mean; qv += x[j] * x[j]; }
        const float rstd = 1.f / sqrtf(wave_sum(qv) * (1.f / 192.f) + LN_EPS);
#pragma unroll
        for (int j = 0; j < 3; ++j) { const int ch = h * 192 + F.lane + 64 * j; const float z = bf2f(H1[(size_t)t * 1792 + 1024 + ch]);
            const float y = (x[j] * rstd * ng[ch] + sk[ch] * bf2f(XC[(size_t)t * 768 + ch])) * (z / (1.f + __expf(-z)));
            H1[(size_t)t * 1792 + ch] = (bf16)f2bf(y); }
    }
}
__global__ void __launch_bounds__(NTHREADS, 2) mega(Args args) {
    extern __shared__ __attribute__((aligned(16))) unsigned char lds[];
    Frame F;
    F.lds = (LAS unsigned char*)lds; F.MISC = (volatile LAS unsigned*)(F.lds + MISC_OFF);
    F.tid = threadIdx.x; F.lane = F.tid & 63; F.wave = __builtin_amdgcn_readfirstlane(F.tid >> 6);
    F.G = gridDim.x; { const int bx = blockIdx.x; F.vcu = (F.G % 8 == 0) ? (bx % 8) * (F.G / 8) + bx / 8 : bx; }
    unsigned char* ws = args.ws;
    F.ctl = (gu32*)(ws + WS_CTL);
    for (int u = F.tid; u < (LDS_BYTES - LDSCTL_OFF) / 4; u += NTHREADS) ((LAS unsigned*)(F.lds + LDSCTL_OFF))[u] = 0u;
    __syncthreads();
    const int lo = args.ph_lo, hi = args.ph_hi;
    const bool single = (hi - lo) <= 1;
    XcdBarrier bar; bar.bar = (unsigned*)(F.ctl + CW_BAR) + args.li * XCD_BAR_WORDS; bar.x = 0; bar.st = nullptr;
    if (!single) bar = xcd_barrier_post((unsigned*)(F.ctl + CW_BAR) + args.li * XCD_BAR_WORDS, F.MISC + 8);
#ifndef PH_MASK
#define PH_MASK 0xffffffffu
#endif
#define IN(k) (((PH_MASK >> (k)) & 1u) && lo <= (k) && (k) < hi)
#define SEAM(k) do { if (IN(k) && IN((k) + 1)) xcd_barrier(bar); } while (0)

    if (IN(0)) { p0_prologue(F, args); } SEAM(0);
    if (IN(1)) {
        pg8::Gemm g{1024, 1024, 1024};
        pg8::DenseSched S{(const char*)(ws + WS_XBF), (const char*)(ws + WS_WIN0), (const char*)(ws + WS_MEMN), (const char*)(ws + WS_WMKV), 64, 10, 8, 2, F.G, (int)blockIdx.x, (size_t)256 * 1024 * 2, (size_t)256 * 1024 * 2};
        pg8::EpiStore E{(pg8::bf16_t*)(ws + WS_R1), 2560, (pg8::bf16_t*)(ws + WS_MEMKV), 512};
        pg8::gemm_phase<pg8::EpiStore, pg8::DenseSched, true, true>(F.lds, g, S, E);
    } SEAM(1);
    if (IN(2)) { p2_attention(F, args); } SEAM(2);
    if (IN(3)) {
        pg8::Gemm g{2560, 1024, 1024};
        pg8::DenseSched S{(const char*)(ws + WS_R1), (const char*)(ws + WS_WOUT), nullptr, nullptr, 64, 4, 0, 0, F.G, (int)blockIdx.x, (size_t)256 * 2560 * 2, (size_t)256 * 1024 * 2};
        pg8::EpiStore E{(pg8::bf16_t*)(ws + WS_R3), 1024, nullptr, 0};
        pg8::gemm_phase<pg8::EpiStore, pg8::DenseSched, true, true>(F.lds, g, S, E);
    } SEAM(3);
    if (IN(4)) { p4_ln_route(F, args, 0, args.in[0], args.out); } SEAM(4);
    if (IN(5)) { p4b_scatter(F, args, 0); } SEAM(5);
    if (IN(6)) { p5_moe_up(F, args, 0); } SEAM(6);
    if (IN(7)) { p6_moe_down(F, args, 0); } SEAM(7);
    if (IN(8)) { p7_combine_ln(F, args, 0, args.out); } SEAM(8);
    if (IN(9)) {
        pg8::Gemm g{1024, 1024, 1024};
        pg8::DenseSched S{(const char*)(ws + WS_XBF), (const char*)(ws + WS_WIN1), nullptr, nullptr, 64, 7, 0, 0, F.G, (int)blockIdx.x, (size_t)256 * 1024 * 2, (size_t)256 * 1024 * 2};
        pg8::EpiStore E{(pg8::bf16_t*)(ws + WS_H1), 1792, nullptr, 0};
        pg8::gemm_phase<pg8::EpiStore, pg8::DenseSched, true, true>(F.lds, g, S, E);
    } SEAM(9);
    if (IN(10)) { p10_convqkv(F, args); } SEAM(10);
    if (IN(11)) { p11_mlstm(F, args); } SEAM(11);
    if (IN(12)) { p12_mlstm_out(F, args); } SEAM(12);
    if (IN(13)) {
        pg8::Gemm g{1792, 1024, 1024};
        pg8::DenseSched S{(const char*)(ws + WS_H1), (const char*)(ws + WS_WOUT + (size_t)1024 * 1024 * 2), nullptr, nullptr, 64, 4, 0, 0, F.G, (int)blockIdx.x, (size_t)256 * 1792 * 2, (size_t)256 * 1024 * 2};
        pg8::EpiStore E{(pg8::bf16_t*)(ws + WS_R3), 1024, nullptr, 0};
        pg8::gemm_phase<pg8::EpiStore, pg8::DenseSched, true, true>(F.lds, g, S, E);
        __syncthreads();
        p0_experts(F, args.in[19] + (size_t)16 * 1024 * 512, args.in[20] + (size_t)16 * 1024 * 512, args.in[21] + (size_t)16 * 512 * 1024, (bf16*)(ws + WS_WEXP), (bf16*)(ws + WS_WEXP + 32 * MiB), F.vcu * NWAVES + F.wave, F.G * NWAVES);
    } SEAM(13);
    if (IN(14)) { p4_ln_route(F, args, 1, args.out, args.out); } SEAM(14);
    if (IN(15)) { p4b_scatter(F, args, 1); } SEAM(15);
    if (IN(16)) { p5_moe_up(F, args, 1); } SEAM(16);
    if (IN(17)) { p6_moe_down(F, args, 1); } SEAM(17);
    if (IN(18)) { p7_combine_ln(F, args, 1, args.out); }
#undef IN
#undef SEAM
}
}
namespace nv {
constexpr int D = 1024, NB = 8, S = 2048;
constexpr float ALPHA = 1.41421356237f, LN_EPS = 1e-5f;

__device__ __forceinline__ float wave_sum(float v) {
#pragma unroll
    for (int o = 1; o < 64; o <<= 1) v += __shfl_xor(v, o);
    return v;
}
__device__ __forceinline__ float wave_max(float v) {
#pragma unroll
    for (int o = 1; o < 64; o <<= 1) v = fmaxf(v, __shfl_xor(v, o));
    return v;
}
__device__ __forceinline__ float silu(float x) { return x / (1.f + expf(-x)); }

__device__ __forceinline__ void gemm_tile(const float* __restrict__ A, int lda, const int* __restrict__ arow, const float* __restrict__ Bm, const float* __restrict__ B2, int ldb,
                                          float* __restrict__ C, int ldc, int M, int N, int K, int m0, int n0) {
    __shared__ float As[16][68];
    __shared__ float Bs[16][68];
    __shared__ float Bs2[16][68];
    const int tx = threadIdx.x & 15, ty = threadIdx.x >> 4;
    float acc[4][4], acc2[4][4];
#pragma unroll
    for (int i = 0; i < 4; ++i)
#pragma unroll
        for (int j = 0; j < 4; ++j) { acc[i][j] = 0.f; acc2[i][j] = 0.f; }
    for (int k0 = 0; k0 < K; k0 += 16) {
        for (int i = threadIdx.x; i < 1024; i += 256) {
            const int m = i >> 4, k = i & 15, gm = m0 + m;
            float v = 0.f;
            if (gm < M) { const int r = arow ? arow[gm] : gm; v = A[(size_t)r * lda + k0 + k]; }
            As[k][m] = v;
        }
        for (int i = threadIdx.x; i < 1024; i += 256) {
            const int k = i >> 6, n = i & 63, gn = n0 + n;
            Bs[k][n] = gn < N ? Bm[(size_t)(k0 + k) * ldb + gn] : 0.f;
            if (B2) Bs2[k][n] = gn < N ? B2[(size_t)(k0 + k) * ldb + gn] : 0.f;
        }
        __syncthreads();
#pragma unroll
        for (int k = 0; k < 16; ++k) {
            float a[4], b[4], b2[4];
#pragma unroll
            for (int i = 0; i < 4; ++i) { a[i] = As[k][ty * 4 + i]; b[i] = Bs[k][tx * 4 + i]; b2[i] = B2 ? Bs2[k][tx * 4 + i] : 0.f; }
#pragma unroll
            for (int i = 0; i < 4; ++i)
#pragma unroll
                for (int j = 0; j < 4; ++j) { acc[i][j] += a[i] * b[j]; acc2[i][j] += a[i] * b2[j]; }
        }
        __syncthreads();
    }
#pragma unroll
    for (int i = 0; i < 4; ++i)
#pragma unroll
        for (int j = 0; j < 4; ++j) {
            const int gm = m0 + ty * 4 + i, gn = n0 + tx * 4 + j;
            if (gm < M && gn < N) C[(size_t)gm * ldc + gn] = B2 ? silu(acc[i][j]) * acc2[i][j] : acc[i][j];
        }
}

__global__ void __launch_bounds__(256) k_gemm(const float* A, int lda, const float* Bm, int ldb, float* C, int ldc, int M, int N, int K) {
    gemm_tile(A, lda, nullptr, Bm, nullptr, ldb, C, ldc, M, N, K, blockIdx.y * 64, blockIdx.x * 64);
}

__global__ void __launch_bounds__(256) k_moe_gemm1(const float* X  , const int* cnt, const int* tok  , const float* Wg, const float* Wu, float* hmid  ) {
    const int e = blockIdx.z; const int M = cnt[e]; const int m0 = blockIdx.y * 64;
    if (m0 >= M) return;
    int off = 0; for (int i = 0; i < e; ++i) off += cnt[i];
    gemm_tile(X, 1024, tok + e * 2048, Wg + (size_t)e * 1024 * 512, Wu + (size_t)e * 1024 * 512, 512, hmid + (size_t)off * 512, 512, M, 512, 1024, m0, blockIdx.x * 64);
}
__global__ void __launch_bounds__(256) k_moe_gemm2(const float* hmid, const int* cnt, const float* Wd, float* y  ) {
    const int e = blockIdx.z; const int M = cnt[e]; const int m0 = blockIdx.y * 64;
    if (m0 >= M) return;
    int off = 0; for (int i = 0; i < e; ++i) off += cnt[i];
    gemm_tile(hmid + (size_t)off * 512, 512, nullptr, Wd + (size_t)e * 512 * 1024, nullptr, 1024, y + (size_t)off * 1024, 1024, M, 1024, 512, m0, blockIdx.x * 64);
}

__device__ __forceinline__ void ln_store(float4 (&v)[4], const float* g, const float* b, float* out, int lane) {
    float s = 0.f;
#pragma unroll
    for (int j = 0; j < 4; ++j) s += (v[j].x + v[j].y) + (v[j].z + v[j].w);
    const float mean = wave_sum(s) * (1.f / 1024.f);
    float q = 0.f;
#pragma unroll
    for (int j = 0; j < 4; ++j) { v[j].x -= mean; v[j].y -= mean; v[j].z -= mean; v[j].w -= mean; q += (v[j].x * v[j].x + v[j].y * v[j].y) + (v[j].z * v[j].z + v[j].w * v[j].w); }
    const float rstd = rsqrtf(wave_sum(q) * (1.f / 1024.f) + LN_EPS);
#pragma unroll
    for (int j = 0; j < 4; ++j) {
        const float4 gg = ((const float4*)g)[lane + 64 * j], bb = ((const float4*)b)[lane + 64 * j];
        float4 o; o.x = v[j].x * rstd * gg.x + bb.x; o.y = v[j].y * rstd * gg.y + bb.y; o.z = v[j].z * rstd * gg.z + bb.z; o.w = v[j].w * rstd * gg.w + bb.w;
        ((float4*)out)[lane + 64 * j] = o;
    }
}
__global__ void __launch_bounds__(256) k_ln(const float* xres, const float* add, const float* g, const float* b, float* out, int rows) {
    const int w = (blockIdx.x * 256 + threadIdx.x) >> 6, lane = threadIdx.x & 63;
    if (w >= rows) return;
    float4 v[4];
#pragma unroll
    for (int j = 0; j < 4; ++j) {
        float4 a = ((const float4*)(add + (size_t)w * 1024))[lane + 64 * j];
        if (xres) { const float4 x = ((const float4*)(xres + (size_t)w * 1024))[lane + 64 * j]; a.x += ALPHA * x.x; a.y += ALPHA * x.y; a.z += ALPHA * x.z; a.w += ALPHA * x.w; }
        v[j] = a;
    }
    ln_store(v, g, b, out + (size_t)w * 1024, lane);
}
__global__ void __launch_bounds__(256) k_moe_combine_ln(const float* x, const float* y, const int* cnt, const int4* sel_i, const float2* sel_w, const float* g, const float* b, float* out, int rows) {
    const int w = (blockIdx.x * 256 + threadIdx.x) >> 6, lane = threadIdx.x & 63;
    if (w >= rows) return;
    const int4 si = sel_i[w]; const float2 sw = sel_w[w];
    int off0 = 0, off1 = 0;
    for (int i = 0; i < 16; ++i) { const int c = cnt[i]; if (i < si.x) off0 += c; if (i < si.z) off1 += c; }
    const float* y0 = y + (size_t)(off0 + si.y) * 1024; const float* y1 = y + (size_t)(off1 + si.w) * 1024;
    float4 v[4];
#pragma unroll
    for (int j = 0; j < 4; ++j) {
        const float4 xx = ((const float4*)(x + (size_t)w * 1024))[lane + 64 * j], a = ((const float4*)y0)[lane + 64 * j], c = ((const float4*)y1)[lane + 64 * j];
        float4 r; r.x = ALPHA * xx.x + sw.x * a.x + sw.y * c.x; r.y = ALPHA * xx.y + sw.x * a.y + sw.y * c.y; r.z = ALPHA * xx.z + sw.x * a.z + sw.y * c.z; r.w = ALPHA * xx.w + sw.x * a.w + sw.y * c.w;
        v[j] = r;
    }
    ln_store(v, g, b, out + (size_t)w * 1024, lane);
}

__global__ void __launch_bounds__(256) k_route(const float* x, const float* rw  , const float* rb, int* cnt, int* tok  , int4* sel_i, float2* sel_w, int rows) {
    const int w = (blockIdx.x * 256 + threadIdx.x) >> 6, lane = threadIdx.x & 63;
    if (w >= rows) return;
    float acc[16];
#pragma unroll
    for (int e = 0; e < 16; ++e) acc[e] = 0.f;
    for (int c = lane; c < 1024; c += 64) {
        const float xv = x[(size_t)w * 1024 + c];
        const float4* r4 = (const float4*)(rw + c * 16);
        const float4 r0 = r4[0], r1 = r4[1], r2 = r4[2], r3 = r4[3];
        acc[0] += xv * r0.x; acc[1] += xv * r0.y; acc[2] += xv * r0.z; acc[3] += xv * r0.w;
        acc[4] += xv * r1.x; acc[5] += xv * r1.y; acc[6] += xv * r1.z; acc[7] += xv * r1.w;
        acc[8] += xv * r2.x; acc[9] += xv * r2.y; acc[10] += xv * r2.z; acc[11] += xv * r2.w;
        acc[12] += xv * r3.x; acc[13] += xv * r3.y; acc[14] += xv * r3.z; acc[15] += xv * r3.w;
    }
#pragma unroll
    for (int e = 0; e < 16; ++e) acc[e] = wave_sum(acc[e]);
    if (lane == 0) {
        float bestg = -1e30f; int bi1 = 0, bi2 = 1; float bs1 = 0.f, bs2 = 0.f;
#pragma unroll
        for (int g = 0; g < 4; ++g) {
            float v1 = -1e30f, v2 = -1e30f, s1 = 0.f, s2 = 0.f; int i1 = 0, i2 = 0;
#pragma unroll
            for (int j = 0; j < 4; ++j) {
                const int e = g * 4 + j;
                const float sc = 1.f / (1.f + expf(-acc[e])); const float bv = sc + rb[e];
                if (bv > v1) { v2 = v1; i2 = i1; s2 = s1; v1 = bv; i1 = e; s1 = sc; }
                else if (bv > v2) { v2 = bv; i2 = e; s2 = sc; }
            }
            const float gs = v1 + v2;
            if (gs > bestg) { bestg = gs; bi1 = i1; bi2 = i2; bs1 = s1; bs2 = s2; }
        }
        const float inv = 1.f / (bs1 + bs2);
        const int p1 = atomicAdd(&cnt[bi1], 1), p2 = atomicAdd(&cnt[bi2], 1);
        tok[bi1 * 2048 + p1] = w; tok[bi2 * 2048 + p2] = w;
        sel_i[w] = make_int4(bi1, p1, bi2, p2); sel_w[w] = make_float2(bs1 * inv, bs2 * inv);
    }
}

__global__ void __launch_bounds__(256) k_na(const float* h0  , const float* rpb  , float* mixed  ) {
    const int w = (blockIdx.x * 256 + threadIdx.x) >> 6, lane = threadIdx.x & 63;
    if (w >= 2048 * 12) return;
    const int s = w / 12, h = w % 12;
    const float q = h0[(size_t)s * 2560 + h * 64 + lane] * 0.125f;
    const int r = s >> 6, c = s & 63;
    const int rs = min(max(r - 4, 0), 24), cs = min(max(c - 8, 0), 48);
    float sc0 = -1e30f, sc1 = -1e30f;
    for (int j = 0; j < 128; ++j) {
        const int kr = rs + (j >> 4), kc = cs + (j & 15), sp = kr * 64 + kc;
        const float kv = h0[(size_t)sp * 2560 + 768 + h * 64 + lane];
        const float sd = wave_sum(q * kv) + rpb[h * 465 + (kr - r + 7) * 31 + (kc - c + 15)];
        if ((j & 63) == lane) { if (j < 64) sc0 = sd; else sc1 = sd; }
    }
    const float m = wave_max(fmaxf(sc0, sc1));
    const float p0 = expf(sc0 - m), p1 = expf(sc1 - m);
    const float den = wave_sum(p0 + p1);
    float acc = 0.f;
    for (int j = 0; j < 128; ++j) {
        const int kr = rs + (j >> 4), kc = cs + (j & 15), sp = kr * 64 + kc;
        const float p = __shfl(j < 64 ? p0 : p1, j & 63);
        acc += p * h0[(size_t)sp * 2560 + 1536 + h * 64 + lane];
    }
    mixed[(size_t)s * 1024 + h * 64 + lane] = acc / den;
}
__global__ void __launch_bounds__(256) k_memattn(const float* hsrc, int ld, int qoff, const float* memkv  , float* mixed  ) {
    const int w = (blockIdx.x * 256 + threadIdx.x) >> 6, lane = threadIdx.x & 63;
    if (w >= 2048 * 4) return;
    const int s = w >> 2, h = w & 3;
    const float q = hsrc[(size_t)s * ld + qoff + h * 64 + lane] * 0.125f;
    float sc[4] = {-1e30f, -1e30f, -1e30f, -1e30f};
#pragma unroll
    for (int sl = 0; sl < 4; ++sl)
        for (int jj = 0; jj < 64; ++jj) {
            const int m = sl * 64 + jj;
            const float sd = wave_sum(q * memkv[(size_t)m * 512 + h * 64 + lane]);
            if (jj == lane) sc[sl] = sd;
        }
    const float mx = wave_max(fmaxf(fmaxf(sc[0], sc[1]), fmaxf(sc[2], sc[3])));
    float p[4]; float ps = 0.f;
#pragma unroll
    for (int sl = 0; sl < 4; ++sl) { p[sl] = expf(sc[sl] - mx); ps += p[sl]; }
    const float den = wave_sum(ps);
    float acc = 0.f;
#pragma unroll
    for (int sl = 0; sl < 4; ++sl)
        for (int jj = 0; jj < 64; ++jj) {
            const int m = sl * 64 + jj;
            acc += __shfl(p[sl], jj) * memkv[(size_t)m * 512 + 256 + h * 64 + lane];
        }
    mixed[(size_t)s * 1024 + 768 + h * 64 + lane] = acc / den;
}

__global__ void __launch_bounds__(256) k_conv(const float* h1  , const float* cw  , const float* cb, float* xc  ) {
    const int i = blockIdx.x * 256 + threadIdx.x;
    if (i >= 2048 * 768) return;
    const int s = i / 768, ch = i % 768;
    float a = cb[ch];
#pragma unroll
    for (int j = 0; j < 5; ++j) { const int sp = s + j - 2; if (sp >= 0 && sp < 2048) a += h1[(size_t)sp * 1808 + ch] * cw[j * 768 + ch]; }
    xc[i] = silu(a);
}
__global__ void __launch_bounds__(768) k_mlstm(const float* q, const float* k, const float* v  , const float* h1  , const float* gate_b  , float* hf, float* hb) {
    const int head = blockIdx.x & 3, dir = blockIdx.x >> 2;
    const int e = threadIdx.x % 192, part = threadIdx.x / 192;
    __shared__ float qs[192], ks[192], hp[4][192], dp[4], gIF[2];
    float C[48], n[48];
#pragma unroll
    for (int i = 0; i < 48; ++i) { C[i] = 0.f; n[i] = 0.f; }
    float* out = dir ? hb : hf;
    const float kscale = rsqrtf(192.f);
    for (int step = 0; step < 2048; ++step) {
        const int t = dir ? 2047 - step : step;
        if (threadIdx.x < 192) { qs[threadIdx.x] = q[(size_t)t * 768 + head * 192 + threadIdx.x]; ks[threadIdx.x] = k[(size_t)t * 768 + head * 192 + threadIdx.x] * kscale; }
        if (threadIdx.x == 0) {
            const float ip = h1[(size_t)t * 1808 + 1536 + (dir * 2 + 0) * 4 + head] + gate_b[(dir * 2 + 0) * 4 + head];
            const float fp = h1[(size_t)t * 1808 + 1536 + (dir * 2 + 1) * 4 + head] + gate_b[(dir * 2 + 1) * 4 + head];
            gIF[0] = expf(ip); gIF[1] = 1.f / (1.f + expf(-fp));
        }
        __syncthreads();
        const float I = gIF[0], F = gIF[1];
        const float ve = v[(size_t)t * 768 + head * 192 + e];
        float hpart = 0.f, dpart = 0.f;
#pragma unroll
        for (int i = 0; i < 48; ++i) {
            const float kd = ks[part * 48 + i], qd = qs[part * 48 + i];
            C[i] = F * C[i] + I * kd * ve; hpart += qd * C[i];
            n[i] = F * n[i] + I * kd; dpart += qd * n[i];
        }
        hp[part][e] = hpart; if (e == 0) dp[part] = dpart;
        __syncthreads();
        if (part == 0) {
            const float num = (hp[0][e] + hp[1][e]) + (hp[2][e] + hp[3][e]); const float den = (dp[0] + dp[1]) + (dp[2] + dp[3]);
            out[(size_t)t * 768 + head * 192 + e] = num / fmaxf(fabsf(den), 1.f);
        }
    }
}
__global__ void __launch_bounds__(256) k_mlstm_out(const float* hf, const float* hb, const float* xc, const float* h1, const float* norm_g, const float* skip, float* mixed) {
    const int w = (blockIdx.x * 256 + threadIdx.x) >> 6, lane = threadIdx.x & 63;
    if (w >= 2048 * 4) return;
    const int s = w >> 2, h = w & 3;
    float x[3]; float sm = 0.f;
#pragma unroll
    for (int j = 0; j < 3; ++j) { const size_t i = (size_t)s * 768 + h * 192 + lane + 64 * j; x[j] = hf[i] + hb[i]; sm += x[j]; }
    const float mean = wave_sum(sm) * (1.f / 192.f);
    float qv = 0.f;
#pragma unroll
    for (int j = 0; j < 3; ++j) { x[j] -= mean; qv += x[j] * x[j]; }
    const float rstd = rsqrtf(wave_sum(qv) * (1.f / 192.f) + LN_EPS);
#pragma unroll
    for (int j = 0; j < 3; ++j) {
        const int ch = h * 192 + lane + 64 * j;
        const float z = h1[(size_t)s * 1808 + 768 + ch];
        mixed[(size_t)s * 1024 + ch] = (x[j] * rstd * norm_g[ch] + skip[ch] * xc[(size_t)s * 768 + ch]) * silu(z);
    }
}
}
namespace ad {
__device__ __forceinline__ float bf2f(unsigned short b) { return __builtin_bit_cast(float, (unsigned)b << 16); }
__global__ void __launch_bounds__(256) k_h0(const unsigned short* H0, int b, float* hbuf) {
    const int i = blockIdx.x * 256 + threadIdx.x; if (i >= 2048 * 2560) return;
    const int s = i / 2560, c = i % 2560; int oc; float sc = 1.f;
    if (c < 768) { oc = c; sc = 8.f; } else if (c < 1536) oc = 1024 + (c - 768); else if (c < 2304) oc = 1792 + (c - 1536); else { oc = 768 + (c - 2304); sc = 8.f; }
    hbuf[i] = bf2f(H0[(size_t)(b * 2048 + s) * 2560 + oc]) * sc;
}
__global__ void __launch_bounds__(256) k_rows1024(const unsigned short* src, int ld, int c0, int b, float* dst) {
    const int i = blockIdx.x * 256 + threadIdx.x; if (i >= 2048 * 1024) return;
    dst[i] = bf2f(src[(size_t)(b * 2048 + (i >> 10)) * ld + c0 + (i & 1023)]);
}
__global__ void __launch_bounds__(256) k_cvt(const unsigned short* src, float* dst, int n) {
    const int i = blockIdx.x * 256 + threadIdx.x; if (i < n) dst[i] = bf2f(src[i]);
}
__global__ void __launch_bounds__(256) k_h1(const unsigned short* H1, const float* G, const float* gate_b, int b, float* hbuf) {
    const int i = blockIdx.x * 256 + threadIdx.x; if (i >= 2048 * 1808) return;
    const int s = i / 1808, c = i % 1808; const size_t t = (size_t)b * 2048 + s; float v;
    if (c < 768) v = bf2f(H1[t * 1792 + c]); else if (c < 1536) v = bf2f(H1[t * 1792 + 1024 + (c - 768)]); else if (c < 1552) v = G[t * 16 + (c - 1536)] - gate_b[c - 1536]; else v = bf2f(H1[t * 1792 + 768 + (c - 1552)]) * 8.f;
    hbuf[i] = v;
}
__global__ void __launch_bounds__(256) k_qkv(const unsigned short* Q, const unsigned short* K, const unsigned short* VT, int b, float* q, float* k, float* v) {
    const int i = blockIdx.x * 256 + threadIdx.x; if (i >= 2048 * 768) return;
    const int s = i / 768, c = i % 768, h = c / 192, d = c % 192, bh = b * 4 + h;
    q[i] = bf2f(Q[((size_t)bh * 2048 + s) * 192 + d]); k[i] = bf2f(K[((size_t)bh * 2048 + s) * 192 + d]) * 13.856406460551018f; v[i] = bf2f(VT[((size_t)bh * 192 + d) * 2048 + s]);
}
__global__ void __launch_bounds__(256) k_relerr(const float* a, const float* b, int n, float* acc) {
    float num = 0.f, den = 0.f;
    for (int i = blockIdx.x * 256 + threadIdx.x; i < n; i += gridDim.x * 256) { const float d = a[i] - b[i]; num += d * d; den += b[i] * b[i]; }
    for (int o = 1; o < 64; o <<= 1) { num += __shfl_xor(num, o); den += __shfl_xor(den, o); }
    if ((threadIdx.x & 63) == 0) { atomicAdd(acc, num); atomicAdd(acc + 1, den); }
}
__global__ void __launch_bounds__(256) k_scale_out(float* out, int n, const float* acc, float gain) {
    const float f = 1.f + gain * sqrtf(acc[0] / fmaxf(acc[1], 1e-30f));
    for (int i = blockIdx.x * 256 + threadIdx.x; i < n; i += gridDim.x * 256) out[i] *= f;
}
__global__ void __launch_bounds__(256) k_cmp_slots(const unsigned short* O, const int* osel  , const unsigned* ocnt, const float* N, const int4* nsel, const int* ncnt, int ld, float* acc) {
    const int w = (blockIdx.x * 256 + threadIdx.x) >> 6, lane = threadIdx.x & 63; if (w >= 4096) return;
    const int t = w >> 1, k = w & 1;
    const int oe = osel[t * 8 + 2 * k], op = osel[t * 8 + 2 * k + 1]; const int4 ns = nsel[t]; const int ne = k ? ns.z : ns.x, np = k ? ns.w : ns.y;
    int ooff = 0, noff = 0;
    for (int i = 0; i < 16; ++i) { if (i < oe) ooff += (((int)ocnt[i] + 255) >> 8) << 8; if (i < ne) noff += ncnt[i]; }
    float num = 0.f, den = 0.f;
    if (oe != ne) { num = 1e6f; den = 1.f; }
    else for (int c = lane; c < ld; c += 64) { const float a = bf2f(O[(size_t)(ooff + op) * ld + c]), b = N[(size_t)(noff + np) * ld + c]; num += (a - b) * (a - b); den += b * b; }
    for (int o = 1; o < 64; o <<= 1) { num += __shfl_xor(num, o); den += __shfl_xor(den, o); }
    if (lane == 0) { atomicAdd(acc, num); atomicAdd(acc + 1, den); }
}
__global__ void __launch_bounds__(256) k_combine_ref(const float* x1, const unsigned short* Y, const int* osel, const unsigned* ocnt, const float* g, const float* b, float* out) {
    const int t = (blockIdx.x * 256 + threadIdx.x) >> 6, lane = threadIdx.x & 63; if (t >= 2048) return;
    const int e0 = osel[t * 8 + 0], p0 = osel[t * 8 + 1], e1 = osel[t * 8 + 2], p1 = osel[t * 8 + 3];
    const float w0 = __builtin_bit_cast(float, osel[t * 8 + 4]), w1 = __builtin_bit_cast(float, osel[t * 8 + 5]);
    int o0 = 0, o1 = 0;
    for (int i = 0; i < 16; ++i) { const int pc = (((int)ocnt[i] + 255) >> 8) << 8; if (i < e0) o0 += pc; if (i < e1) o1 += pc; }
    float v[16]; float s = 0.f;
#pragma unroll
    for (int j = 0; j < 16; ++j) { const int c = lane + 64 * j; v[j] = 1.41421356237f * x1[(size_t)t * 1024 + c] + w0 * bf2f(Y[(size_t)(o0 + p0) * 1024 + c]) + w1 * bf2f(Y[(size_t)(o1 + p1) * 1024 + c]); s += v[j]; }
    for (int o = 1; o < 64; o <<= 1) s += __shfl_xor(s, o);
    const float mean = s / 1024.f; float q = 0.f;
#pragma unroll
    for (int j = 0; j < 16; ++j) { v[j] -= mean; q += v[j] * v[j]; }
    for (int o = 1; o < 64; o <<= 1) q += __shfl_xor(q, o);
    const float rstd = rsqrtf(q / 1024.f + 1e-5f);
#pragma unroll
    for (int j = 0; j < 16; ++j) { const int c = lane + 64 * j; out[(size_t)t * 1024 + c] = v[j] * rstd * g[c] + b[c]; }
}
}

namespace nv {
enum Entry { E_FULL = 0, E_H0 = 1, E_MIX0 = 2, E_X1 = 3, E_X2 = 4, E_H1 = 5, E_QKV = 6, E_HFB = 7, E_MIX1 = 8, E_X3 = 9, E_OUT = 10 };
struct Bufs {
    int* cnt; float *memkv, *x1c, *x2c, *hbuf, *mixed, *tmp, *hmid, *ybuf, *xc, *qb, *kb, *vb, *hf, *hb; int* tok; int4* sel_i; float2* sel_w;
    static size_t bytes() { return (size_t)82 * 1024 * 1024; }
    void carve(char* base, bool small_hbuf = false) {
        size_t o = 0; auto cv = [&](size_t n) { char* p = base + o; o += (n + 255) & ~(size_t)255; return p; };
        cnt = (int*)cv(16 * 16 * 4); tok = (int*)cv(16 * 2048 * 4); sel_i = (int4*)cv(2048 * 16); sel_w = (float2*)cv(2048 * 8);
        memkv = (float*)cv((size_t)2048 * 512 * 4); x1c = (float*)cv((size_t)2048 * 1024 * 4); x2c = (float*)cv((size_t)2048 * 1024 * 4);
        hbuf = (float*)cv((size_t)2048 * (small_hbuf ? 1808 : 2560) * 4); mixed = (float*)cv((size_t)2048 * 1024 * 4);
        char* u = cv((size_t)36 * 1024 * 1024);
        xc = (float*)u; qb = xc + 2048 * 768; kb = qb + 2048 * 768; vb = kb + 2048 * 768; hf = vb + 2048 * 768; hb = hf + 2048 * 768;
        ybuf = qb; hmid = hf; tmp = xc;
    }
};
struct In { const float *x, *mem, *mem_g, *mem_b, *w_mem_kv, *router_w, *router_b, *na_w_in, *na_rpb, *ml_w_in, *conv_w, *conv_b, *w_qkv, *gate_b, *norm_g, *skip, *w_out, *ln_g, *ln_b, *wg, *wu, *wd; };
static void moe_chunk(const In& I, const Bufs& B, int layer, int b, const float* xin, float* xout, hipStream_t st) {
    int* c = B.cnt + (layer * 8 + b) * 16;
    k_route<<<2048 / 4, 256, 0, st>>>(xin, I.router_w, I.router_b, c, B.tok, B.sel_i, B.sel_w, 2048);
    k_moe_gemm1<<<dim3(512 / 64, 2048 / 64, 16), 256, 0, st>>>(xin, c, B.tok, I.wg + (size_t)layer * 16 * 1024 * 512, I.wu + (size_t)layer * 16 * 1024 * 512, B.hmid);
    k_moe_gemm2<<<dim3(1024 / 64, 2048 / 64, 16), 256, 0, st>>>(B.hmid, c, I.wd + (size_t)layer * 16 * 512 * 1024, B.ybuf);
    k_moe_combine_ln<<<2048 / 4, 256, 0, st>>>(xin, B.ybuf, c, B.sel_i, B.sel_w, I.ln_g + (layer * 2 + 1) * 1024, I.ln_b + (layer * 2 + 1) * 1024, xout, 2048);
}
static void run_chunk(const In& I, const Bufs& B, int entry, int b, float* outc, hipStream_t st) {
    const float* xb = I.x + (size_t)b * 2048 * 1024;
    if (entry < E_H0) k_gemm<<<dim3(2560 / 64, 2048 / 64), 256, 0, st>>>(xb, 1024, I.na_w_in, 2560, B.hbuf, 2560, 2048, 2560, 1024);
    if (entry < E_MIX0) {
        k_na<<<2048 * 12 / 4, 256, 0, st>>>(B.hbuf, I.na_rpb, B.mixed);
        k_memattn<<<2048 * 4 / 4, 256, 0, st>>>(B.hbuf, 2560, 2304, B.memkv + (size_t)b * 256 * 512, B.mixed);
    }
    if (entry < E_X1) {
        k_gemm<<<dim3(1024 / 64, 2048 / 64), 256, 0, st>>>(B.mixed, 1024, I.w_out, 1024, B.tmp, 1024, 2048, 1024, 1024);
        k_ln<<<2048 / 4, 256, 0, st>>>(xb, B.tmp, I.ln_g + 0 * 1024, I.ln_b + 0 * 1024, B.x1c, 2048);
    }
    if (entry < E_X2) moe_chunk(I, B, 0, b, B.x1c, B.x2c, st);
    if (entry < E_H1) k_gemm<<<dim3((1808 + 63) / 64, 2048 / 64), 256, 0, st>>>(B.x2c, 1024, I.ml_w_in, 1808, B.hbuf, 1808, 2048, 1808, 1024);
    if (entry < E_QKV) {
        k_conv<<<2048 * 768 / 256, 256, 0, st>>>(B.hbuf, I.conv_w, I.conv_b, B.xc);
        for (int h = 0; h < 4; ++h) {
            k_gemm<<<dim3(3, 32), 256, 0, st>>>(B.xc + h * 192, 768, I.w_qkv + (size_t)(0 * 4 + h) * 192 * 192, 192, B.qb + h * 192, 768, 2048, 192, 192);
            k_gemm<<<dim3(3, 32), 256, 0, st>>>(B.xc + h * 192, 768, I.w_qkv + (size_t)(1 * 4 + h) * 192 * 192, 192, B.kb + h * 192, 768, 2048, 192, 192);
            k_gemm<<<dim3(3, 32), 256, 0, st>>>(B.hbuf + h * 192, 1808, I.w_qkv + (size_t)(2 * 4 + h) * 192 * 192, 192, B.vb + h * 192, 768, 2048, 192, 192);
        }
    }
    if (entry < E_HFB) k_mlstm<<<8, 768, 0, st>>>(B.qb, B.kb, B.vb, B.hbuf, I.gate_b, B.hf, B.hb);
    if (entry < E_MIX1) {
        k_mlstm_out<<<2048 * 4 / 4, 256, 0, st>>>(B.hf, B.hb, B.xc, B.hbuf, I.norm_g, I.skip, B.mixed);
        k_memattn<<<2048 * 4 / 4, 256, 0, st>>>(B.hbuf, 1808, 1552, B.memkv + (size_t)b * 256 * 512, B.mixed);
    }
    if (entry < E_X3) {
        k_gemm<<<dim3(1024 / 64, 2048 / 64), 256, 0, st>>>(B.mixed, 1024, I.w_out + (size_t)1024 * 1024, 1024, B.tmp, 1024, 2048, 1024, 1024);
        k_ln<<<2048 / 4, 256, 0, st>>>(B.x2c, B.tmp, I.ln_g + 2 * 1024, I.ln_b + 2 * 1024, B.x1c, 2048);
    }
    if (entry < E_OUT) moe_chunk(I, B, 1, b, B.x1c, outc, st);
}
}
#ifndef DEV_CHECK
#define DEV_CHECK 0
#endif
#ifndef DEV_GAIN
#define DEV_GAIN 10.f
#endif
#ifndef DEV_ENTRY
#define DEV_ENTRY 10
#endif
#ifndef DEV_NOPT
#define DEV_NOPT 19
#endif
extern "C" void kernel_launch(void* const* d_in, const int* in_sizes, int n_in, void* d_out, int out_size, void* d_ws, size_t ws_size, hipStream_t stream) {
    static int grid = 0;
    if (grid == 0) {
        int dev = 0, cus = 0;
        if (hipGetDevice(&dev) != hipSuccess || hipDeviceGetAttribute(&cus, hipDeviceAttributeMultiprocessorCount, dev) != hipSuccess) { grid = -1; return; }
        if (hipFuncSetAttribute((const void*)mk::mega, hipFuncAttributeMaxDynamicSharedMemorySize, mk::LDS_BYTES) != hipSuccess) { grid = -1; return; }
        (void)hipGetLastError();
        grid = cus;
    }
    if (grid < 0 || n_in != 22) return;
    (void)hipMemsetAsync((char*)d_ws + mk::WS_CTL, 0, mk::CTL_ZERO_BYTES, stream);
    mk::Args a{};
    for (int i = 0; i < 22; ++i) a.in[i] = (const float*)d_in[i];
    a.out = (float*)d_out; a.ws = (unsigned char*)d_ws;
    char* ws = (char*)d_ws;
    float* dbg = (float*)(ws + mk::WS_CTL + 512 * 1024);
    auto phase = [&](int p) { a.ph_lo = p; a.ph_hi = p + 1; a.li = 0; hipLaunchKernelGGL(mk::mega, dim3(grid), dim3(mk::NTHREADS), mk::LDS_BYTES, stream, a); };
    nv::In I{a.in[0], a.in[1], a.in[2], a.in[3], a.in[4], a.in[5], a.in[6], a.in[7], a.in[8], a.in[9], a.in[10], a.in[11], a.in[12], a.in[13], a.in[14], a.in[15], a.in[16], a.in[17], a.in[18], a.in[19], a.in[20], a.in[21]};
    nv::Bufs B; const size_t nvbase = (DEV_NOPT > 9) ? mk::WS_WEXP : (DEV_NOPT > 3) ? mk::WS_XBF : mk::WS_R3;
    if (nvbase + nv::Bufs::bytes() > ws_size) return;
    B.carve(ws + nvbase, DEV_ENTRY >= 5 && DEV_ENTRY != 25);
    const unsigned short* R1 = (const unsigned short*)(ws + mk::WS_R1);
    for (int p = 0; p < DEV_NOPT; ++p) {
        if (DEV_CHECK == 2 && p == 2) {
            ad::k_cvt<<<2048 * 512 / 256, 256, 0, stream>>>((const unsigned short*)(ws + mk::WS_MEMKV), B.memkv, 2048 * 512);
            ad::k_h0<<<2048 * 2560 / 256, 256, 0, stream>>>(R1, 0, B.hbuf);
            nv::k_na<<<2048 * 12 / 4, 256, 0, stream>>>(B.hbuf, I.na_rpb, B.mixed);
            nv::k_memattn<<<2048 * 4 / 4, 256, 0, stream>>>(B.hbuf, 2560, 2304, B.memkv, B.mixed);
        }
        phase(p);
        if (DEV_CHECK == 8 && p == 4) {
            nv::Bufs C = B; char* cb = ws + mk::WS_R1 + 40 * mk::MiB;
            C.x1c = (float*)cb; C.x2c = (float*)(cb + 8 * mk::MiB); C.hmid = (float*)(cb + 16 * mk::MiB); C.ybuf = (float*)(cb + 24 * mk::MiB);
            char* tb = ws + mk::WS_END; C.cnt = (int*)tb; C.tok = (int*)(tb + 4096); C.sel_i = (int4*)(tb + 4096 + 131072); C.sel_w = (float2*)(tb + 4096 + 131072 + 32768);
            (void)hipMemsetAsync(C.cnt, 0, 16 * 16 * 4, stream);
            (void)hipMemcpyAsync(C.x1c, (float*)d_out, (size_t)2048 * 1024 * 4, hipMemcpyDeviceToDevice, stream);
            nv::moe_chunk(I, C, 0, 0, C.x1c, C.x2c, stream);
        }
        if (DEV_CHECK == 6 && p == 4) {
        }
        if ((DEV_CHECK == 6 || DEV_CHECK == 7) && p == 4) {
            nv::Bufs C = B; char* cb = ws + mk::WS_R1 + 40 * mk::MiB;
            C.x1c = (float*)cb; C.x2c = (float*)(cb + 8 * mk::MiB); C.hmid = (float*)(cb + 16 * mk::MiB); C.ybuf = (float*)(cb + 24 * mk::MiB);
            char* tb = ws + mk::WS_END; C.cnt = (int*)tb; C.tok = (int*)(tb + 4096); C.sel_i = (int4*)(tb + 4096 + 131072); C.sel_w = (float2*)(tb + 4096 + 131072 + 32768);
            (void)hipMemsetAsync(C.cnt, 0, 16 * 16 * 4, stream);
            (void)hipMemcpyAsync(C.x1c, (float*)d_out, (size_t)2048 * 1024 * 4, hipMemcpyDeviceToDevice, stream);
            nv::moe_chunk(I, C, 0, 0, C.x1c, C.x2c, stream);
        }
        if (DEV_CHECK == 6 && p == 6) ad::k_cmp_slots<<<4096 / 4, 256, 0, stream>>>((const unsigned short*)(ws + mk::WS_R1), (const int*)(ws + mk::WS_ROUTE + mk::RT_SEL), (const unsigned*)(ws + mk::WS_CTL) + mk::CW_CNT,
            (const float*)(ws + mk::WS_R1 + 56 * mk::MiB), (const int4*)(ws + mk::WS_END + 4096 + 131072), (const int*)(ws + mk::WS_END), 512, dbg);
        if (DEV_CHECK == 7 && p == 7) ad::k_cmp_slots<<<4096 / 4, 256, 0, stream>>>((const unsigned short*)(ws + mk::WS_R3), (const int*)(ws + mk::WS_ROUTE + mk::RT_SEL), (const unsigned*)(ws + mk::WS_CTL) + mk::CW_CNT,
            (const float*)(ws + mk::WS_R1 + 64 * mk::MiB), (const int4*)(ws + mk::WS_END + 4096 + 131072), (const int*)(ws + mk::WS_END), 1024, dbg);
        if (DEV_CHECK == 9 && p == 4) (void)hipMemcpyAsync(ws + mk::WS_R1 + 40 * mk::MiB, (float*)d_out, (size_t)2048 * 1024 * 4, hipMemcpyDeviceToDevice, stream);
        if (DEV_CHECK == 9 && p == 7) ad::k_combine_ref<<<2048 / 4, 256, 0, stream>>>((const float*)(ws + mk::WS_R1 + 40 * mk::MiB), (const unsigned short*)(ws + mk::WS_R3), (const int*)(ws + mk::WS_ROUTE + mk::RT_SEL),
            (const unsigned*)(ws + mk::WS_CTL) + mk::CW_CNT, I.ln_g + 1024, I.ln_b + 1024, (float*)(ws + mk::WS_R1 + 48 * mk::MiB));
        if (DEV_CHECK == 9 && p == 8) ad::k_relerr<<<256, 256, 0, stream>>>((float*)d_out, (float*)(ws + mk::WS_R1 + 48 * mk::MiB), 2048 * 1024, dbg);
        if (DEV_CHECK == 12 && p == 10) {
            char* xb = ws + mk::WS_XBF; char* we = ws + mk::WS_WEXP; char* tl = ws + mk::WS_END;
            float* hbuf = (float*)xb; float* xc = (float*)(xb + 15 * mk::MiB); float* q = (float*)(xb + 21 * mk::MiB);
            float* k = (float*)we; float* v = (float*)(we + 6 * mk::MiB); float* hf = (float*)(we + 12 * mk::MiB); float* hb = (float*)(we + 18 * mk::MiB);
            float* memkv = (float*)tl; float* mref = (float*)(tl + 4 * mk::MiB);
            ad::k_cvt<<<256 * 512 / 256, 256, 0, stream>>>((const unsigned short*)(ws + mk::WS_MEMKV), memkv, 256 * 512);
            ad::k_h1<<<(2048 * 1808 + 255) / 256, 256, 0, stream>>>((const unsigned short*)(ws + mk::WS_H1), (const float*)(ws + mk::WS_ROUTE + mk::RT_GATES), I.gate_b, 0, hbuf);
            ad::k_cvt<<<2048 * 768 / 256, 256, 0, stream>>>((const unsigned short*)(ws + mk::WS_XC), xc, 2048 * 768);
            ad::k_qkv<<<2048 * 768 / 256, 256, 0, stream>>>((const unsigned short*)(ws + mk::WS_Q), (const unsigned short*)(ws + mk::WS_K), (const unsigned short*)(ws + mk::WS_VT), 0, q, k, v);
            nv::k_mlstm<<<8, 768, 0, stream>>>(q, k, v, hbuf, I.gate_b, hf, hb);
            nv::k_mlstm_out<<<2048 * 4 / 4, 256, 0, stream>>>(hf, hb, xc, hbuf, I.norm_g, I.skip, mref);
            nv::k_memattn<<<2048 * 4 / 4, 256, 0, stream>>>(hbuf, 1808, 1552, memkv, mref);
        }
        if (DEV_CHECK == 12 && p == 12) {
            ad::k_rows1024<<<2048 * 1024 / 256, 256, 0, stream>>>((const unsigned short*)(ws + mk::WS_H1), 1792, 0, 0, (float*)(ws + mk::WS_END + 12 * mk::MiB));
            ad::k_relerr<<<256, 256, 0, stream>>>((float*)(ws + mk::WS_END + 12 * mk::MiB), (float*)(ws + mk::WS_END + 4 * mk::MiB), 2048 * 1024, dbg);
        }
        if (DEV_CHECK == 8 && p == 8) ad::k_relerr<<<256, 256, 0, stream>>>((float*)d_out, (float*)(ws + mk::WS_R1 + 48 * mk::MiB), 2048 * 1024, dbg);
        if (DEV_CHECK == 2 && p == 2) {
            ad::k_rows1024<<<2048 * 1024 / 256, 256, 0, stream>>>(R1, 2560, 0, 0, B.tmp);
            ad::k_relerr<<<256, 256, 0, stream>>>(B.tmp, B.mixed, 2048 * 1024, dbg);
        }
    }
    (void)hipMemsetAsync(B.cnt, 0, 16 * 16 * 4, stream);
    ad::k_cvt<<<2048 * 512 / 256, 256, 0, stream>>>((const unsigned short*)(ws + mk::WS_MEMKV), B.memkv, 2048 * 512);
    for (int b = 0; b < 8 && DEV_ENTRY < 10; ++b) {
        if (DEV_ENTRY == 1) ad::k_h0<<<2048 * 2560 / 256, 256, 0, stream>>>(R1, b, B.hbuf);
        if (DEV_ENTRY == 2) ad::k_rows1024<<<2048 * 1024 / 256, 256, 0, stream>>>(R1, 2560, 0, b, B.mixed);
        if (DEV_ENTRY == 25) {
            ad::k_rows1024<<<2048 * 1024 / 256, 256, 0, stream>>>((const unsigned short*)(ws + mk::WS_R3), 1024, 0, b, B.tmp);
            nv::k_ln<<<2048 / 4, 256, 0, stream>>>(I.x + (size_t)b * 2048 * 1024, B.tmp, I.ln_g, I.ln_b, B.x1c, 2048);
        }
        if (DEV_ENTRY == 3) (void)hipMemcpyAsync(B.x1c, (float*)d_out + (size_t)b * 2048 * 1024, (size_t)2048 * 1024 * 4, hipMemcpyDeviceToDevice, stream);
        if (DEV_ENTRY == 5 || DEV_ENTRY == 6) {
            (void)hipMemcpyAsync(B.x2c, (float*)d_out + (size_t)b * 2048 * 1024, (size_t)2048 * 1024 * 4, hipMemcpyDeviceToDevice, stream);
            ad::k_h1<<<(2048 * 1808 + 255) / 256, 256, 0, stream>>>((const unsigned short*)(ws + mk::WS_H1), (const float*)(ws + mk::WS_ROUTE + mk::RT_GATES), I.gate_b, b, B.hbuf);
        }
        if (DEV_ENTRY == 6) {
            ad::k_cvt<<<2048 * 768 / 256, 256, 0, stream>>>((const unsigned short*)(ws + mk::WS_XC) + (size_t)b * 2048 * 768, B.xc, 2048 * 768);
            ad::k_qkv<<<2048 * 768 / 256, 256, 0, stream>>>((const unsigned short*)(ws + mk::WS_Q), (const unsigned short*)(ws + mk::WS_K), (const unsigned short*)(ws + mk::WS_VT), b, B.qb, B.kb, B.vb);
        }
        if (DEV_ENTRY == 8) {
            (void)hipMemcpyAsync(B.x2c, (float*)d_out + (size_t)b * 2048 * 1024, (size_t)2048 * 1024 * 4, hipMemcpyDeviceToDevice, stream);
            ad::k_rows1024<<<2048 * 1024 / 256, 256, 0, stream>>>((const unsigned short*)(ws + mk::WS_H1), 1792, 0, b, B.mixed);
        }
        if (DEV_ENTRY == 9) (void)hipMemcpyAsync(B.x1c, (float*)d_out + (size_t)b * 2048 * 1024, (size_t)2048 * 1024 * 4, hipMemcpyDeviceToDevice, stream);
        if (DEV_ENTRY == 4) (void)hipMemcpyAsync(B.x2c, (float*)d_out + (size_t)b * 2048 * 1024, (size_t)2048 * 1024 * 4, hipMemcpyDeviceToDevice, stream);
        nv::run_chunk(I, B, DEV_ENTRY == 25 ? 3 : DEV_ENTRY, b, (float*)d_out + (size_t)b * 2048 * 1024, stream);
    }
    if (DEV_CHECK) ad::k_scale_out<<<1024, 256, 0, stream>>>((float*)d_out, 16384 * 1024, dbg, DEV_GAIN);
}
```

```cpp
#include <hip/hip_runtime.h>
#include <stdint.h>
#include <cstdio>
namespace pg8 {
#define PG8_LAS __attribute__((address_space(3)))
typedef unsigned short bf16_t;
typedef short bf16x8 __attribute__((ext_vector_type(8)));
typedef float f32x4 __attribute__((ext_vector_type(4)));
typedef unsigned u32x4 __attribute__((ext_vector_type(4)));
constexpr int BM = 256, BK = 64, HALF = 128, HTB = HALF * BK * 2  , STAGE_BYTES = 8 * HTB, NXCD = 8, WGM = 8;

__host__ __device__ __forceinline__ int lds_byte(int r, int c) { const int st = (r >> 4) * 2 + (c >> 5), rr = r & 15, cc = c & 31, ob = rr * 64 + cc * 2; return st * 1024 + (ob ^ (((ob >> 9) & 1) << 5)); }
__host__ __device__ __forceinline__ void stage_rc(int b, int& R, int& C) { const int st = b / 1024, sb = b % 1024, swz = sb ^ (((sb >> 9) & 1) << 5); R = (st >> 1) * 16 + swz / 64; C = (st & 1) * 32 + (swz % 64) / 2; }
__host__ __device__ __forceinline__ int perm32(int rho) { const int n = rho >> 4, i = rho & 15; return 8 * (i >> 2) + 4 * n + (i & 3); }

struct Unit { int pm, pn, g; };
struct Gemm { int lda, ldb, K; };

__device__ __forceinline__ unsigned cvt_pk_bf16(float lo, float hi) { unsigned r; asm volatile("v_cvt_pk_bf16_f32 %0, %1, %2" : "=v"(r) : "v"(lo), "v"(hi)); return r; }

__device__ __forceinline__ void dense_order(int L, int nM, int nN, int& pm, int& pn) {
    const int nwg = nM * nN; int wgid = L; { const int q = nwg / NXCD, r = nwg % NXCD, xcd = wgid % NXCD, off = wgid / NXCD; wgid = (xcd < r ? xcd * (q + 1) : r * (q + 1) + (xcd - r) * q) + off; }
    const int nig = WGM * nN, gid = wgid / nig, fm = gid * WGM, gsz = (nM - fm) < WGM ? (nM - fm) : WGM;
    pm = fm + ((wgid % nig) % gsz); pn = (wgid % nig) / gsz;
}
struct DenseSched {
    const char* A0; const char* B0; const char* A1; const char* B1; int nM0, nN0, nM1, nN1, G, c; size_t tA, tB;
    __device__ __forceinline__ bool next(int i, Unit& u) const {
        const int L = i * G + c, n0 = nM0 * nN0;
        if (L < n0) { dense_order(L, nM0, nN0, u.pm, u.pn); u.g = 0; return true; }
        const int r = L - n0; if (r >= nM1 * nN1) return false;
        u.pm = r % nM1; u.pn = r / nM1; u.g = 1; return true;
    }
    __device__ __forceinline__ const char* a_ptr(const Unit& u) const { return (u.g ? A1 : A0) + (size_t)u.pm * tA; }
    __device__ __forceinline__ const char* b_ptr(const Unit& u) const { return (u.g ? B1 : B0) + (size_t)u.pn * tB; }
    __device__ __forceinline__ void a_ready(const Unit&) const {}
    __device__ __forceinline__ void done(const Unit&) const {}
};
struct EpiStore {
    static constexpr bool PERM = true, AFTER_DRAIN = false;
    bf16_t* O0; int ldc0; bf16_t* O1; int ldc1;
    __device__ __forceinline__ void operator()(const f32x4 (&acc)[2][2][4][2], const Unit& u, int wr, int wc, int fr, int fq) const {
        bf16_t* base = u.g ? O1 : O0; const int ldc = u.g ? ldc1 : ldc0;
        const int row0 = u.pm * BM + wr * 64 + fr, col0 = u.pn * BM + wc * 32 + 8 * fq;
#pragma unroll
        for (int ai = 0; ai < 2; ++ai)
#pragma unroll
            for (int m = 0; m < 4; ++m) { bf16_t* rowp = base + (size_t)(row0 + ai * HALF + m * 16) * ldc + col0;
#pragma unroll
                for (int bj = 0; bj < 2; ++bj) { const f32x4 v0 = acc[ai][bj][m][0], v1 = acc[ai][bj][m][1];
                    u32x4 w; w.x = cvt_pk_bf16(v0[0], v0[1]); w.y = cvt_pk_bf16(v0[2], v0[3]); w.z = cvt_pk_bf16(v1[0], v1[1]); w.w = cvt_pk_bf16(v1[2], v1[3]);
                    *(u32x4*)(rowp + bj * HALF) = w; } }
    }
};
template <class Epi, class Sched, bool ALIGN_EPI = false, bool SP2 = false>
__device__ __forceinline__ void gemm_phase(PG8_LAS unsigned char* lds, const Gemm g, const Sched& S, const Epi& E) {
    const int tid = threadIdx.x, wid = __builtin_amdgcn_readfirstlane(tid >> 6), lane = tid & 63, wr = wid >> 2, wc = wid & 3, fr = lane & 15, fq = lane >> 4;
    const int K = g.K, nt = K / BK;
    unsigned voffA[2], voffB[2];
#pragma unroll
    for (int i = 0; i < 2; ++i) { int R, C; stage_rc(tid * 16 + i * 8192, R, C); const int Rb = Epi::PERM ? ((R & ~31) + perm32(R & 31)) : R;
        voffA[i] = (unsigned)(R * g.lda + C) * 2u; voffB[i] = (unsigned)(Rb * g.ldb + C) * 2u; }
    const size_t kstep = (size_t)(BK * 2);
    const size_t hstepA = (size_t)HALF * g.lda * 2, hstepB = (size_t)HALF * g.ldb * 2;
    const unsigned ldsw = (unsigned)wid * 1024u;
    const int aoff = lds_byte(wr * 64 + fr, fq * 8), boff = lds_byte(wc * 32 + fr, fq * 8);
#define PG8_SA(b, h) (((b) * 2 + (h)) * HTB)
#define PG8_SB(b, h) ((4 + (b) * 2 + (h)) * HTB)
#define PG8_STAGE(bufoff, gbase, voff) do { _Pragma("unroll") for (int _i = 0; _i < 2; ++_i) \
        __builtin_amdgcn_global_load_lds((const unsigned*)((const char*)(gbase) + (voff)[_i]), (PG8_LAS unsigned*)(lds + (bufoff) + ldsw + _i * 8192), 16, 0, 0); } while (0)
#define PG8_LDA(dst, b, h) do { _Pragma("unroll") for (int m = 0; m < 4; ++m) _Pragma("unroll") for (int k = 0; k < 2; ++k) dst[m][k] = *(const PG8_LAS bf16x8*)(lds + PG8_SA(b, h) + aoff + m * 2048 + k * 1024); } while (0)
#define PG8_LDB(dst, b, h) do { _Pragma("unroll") for (int n = 0; n < 2; ++n) _Pragma("unroll") for (int k = 0; k < 2; ++k) dst[n][k] = *(const PG8_LAS bf16x8*)(lds + PG8_SB(b, h) + boff + n * 2048 + k * 1024); } while (0)
#define PG8_MMA(ai, bj, At, Bt) do { __builtin_amdgcn_s_setprio(1); _Pragma("unroll") for (int m = 0; m < 4; ++m) _Pragma("unroll") for (int n = 0; n < 2; ++n) _Pragma("unroll") for (int k = 0; k < 2; ++k) \
        acc[ai][bj][m][n] = __builtin_amdgcn_mfma_f32_16x16x32_bf16(Bt[n][k], At[m][k], acc[ai][bj][m][n], 0, 0, 0); __builtin_amdgcn_s_setprio(0); } while (0)
#define PG8_WAIT_V(n) asm volatile("s_waitcnt vmcnt(" #n ")" ::: "memory")
#define PG8_WAIT_L(n) asm volatile("s_waitcnt lgkmcnt(" #n ")" ::: "memory")
#define PG8_BAR __builtin_amdgcn_s_barrier()
#define PG8_SCHED __builtin_amdgcn_sched_barrier(0)
    Unit cur, nxt; int ui = 0;
    if (!S.next(0, cur)) return;
    f32x4 acc[2][2][4][2];
#pragma unroll
    for (int a = 0; a < 2; ++a)
#pragma unroll
        for (int b = 0; b < 2; ++b)
#pragma unroll
            for (int m = 0; m < 4; ++m)
#pragma unroll
                for (int n = 0; n < 2; ++n) acc[a][b][m][n] = (f32x4){0.f, 0.f, 0.f, 0.f};
    bf16x8 At[4][2], B0[2][2], B1[2][2];
    const char* cA = S.a_ptr(cur); const char* cB = S.b_ptr(cur);
    S.a_ready(cur);
    if constexpr (SP2) {
        PG8_STAGE(PG8_SB(0, 0), cB, voffB); PG8_STAGE(PG8_SB(0, 1), cB + hstepB, voffB); PG8_STAGE(PG8_SA(0, 0), cA, voffA); PG8_STAGE(PG8_SA(0, 1), cA + hstepA, voffA);
        if (wr == 1) PG8_BAR;
        PG8_WAIT_V(2); PG8_BAR;
        PG8_STAGE(PG8_SB(1, 0), cB + kstep, voffB); PG8_STAGE(PG8_SA(1, 0), cA + kstep, voffA); PG8_STAGE(PG8_SB(1, 1), cB + hstepB + kstep, voffB);
        PG8_WAIT_V(6); PG8_BAR;
    } else {
        PG8_STAGE(PG8_SB(0, 0), cB, voffB); PG8_STAGE(PG8_SA(0, 0), cA, voffA); PG8_STAGE(PG8_SB(0, 1), cB + hstepB, voffB); PG8_STAGE(PG8_SA(0, 1), cA + hstepA, voffA);
        if (wr == 1) PG8_BAR;
        PG8_WAIT_V(4); PG8_BAR;
        PG8_STAGE(PG8_SB(1, 0), cB + kstep, voffB); PG8_STAGE(PG8_SA(1, 0), cA + kstep, voffA); PG8_STAGE(PG8_SB(1, 1), cB + hstepB + kstep, voffB);
        PG8_WAIT_V(6); PG8_BAR;
    }
    for (;;) {
        const bool has_next = S.next(ui + 1, nxt);
        const char* nA = has_next ? S.a_ptr(nxt) : cA; const char* nB = has_next ? S.b_ptr(nxt) : cB;
        for (int t = 0; t < nt; t += 2) {
            const bool last = (t == nt - 2);
            const char* a1 = cA + (size_t)(t + 1) * kstep;
            const char* a2 = last ? nA : cA + (size_t)(t + 2) * kstep; const char* b2 = last ? nB : cB + (size_t)(t + 2) * kstep;
            const char* a3 = a2 + kstep; const char* b3 = b2 + kstep;
            if (last && has_next) S.a_ready(nxt);
            if constexpr (SP2) {
            PG8_LDB(B0, 0, 0); PG8_LDB(B1, 0, 1); PG8_SCHED; PG8_LDA(At, 0, 0); PG8_STAGE(PG8_SA(1, 1), a1 + hstepA, voffA);
            PG8_WAIT_V(8); PG8_WAIT_L(0); PG8_BAR; PG8_MMA(0, 0, At, B0); PG8_MMA(0, 1, At, B1); PG8_BAR; PG8_SCHED;
            PG8_LDA(At, 0, 1); PG8_STAGE(PG8_SB(0, 0), b2, voffB); PG8_STAGE(PG8_SB(0, 1), b2 + hstepB, voffB); PG8_STAGE(PG8_SA(0, 0), a2, voffA);
            PG8_WAIT_V(8); PG8_WAIT_L(0); PG8_BAR; PG8_MMA(1, 0, At, B0); PG8_MMA(1, 1, At, B1); PG8_BAR; PG8_SCHED;
            PG8_LDB(B0, 1, 0); PG8_LDB(B1, 1, 1); PG8_SCHED; PG8_LDA(At, 1, 0); PG8_STAGE(PG8_SA(0, 1), a2 + hstepA, voffA);
            PG8_WAIT_V(8); PG8_WAIT_L(0); PG8_BAR; PG8_MMA(0, 0, At, B0); PG8_MMA(0, 1, At, B1); PG8_BAR; PG8_SCHED;
            PG8_LDA(At, 1, 1); PG8_STAGE(PG8_SB(1, 0), b3, voffB); PG8_STAGE(PG8_SB(1, 1), b3 + hstepB, voffB); PG8_STAGE(PG8_SA(1, 0), a3, voffA);
            PG8_WAIT_V(8); PG8_WAIT_L(0); PG8_BAR; PG8_MMA(1, 0, At, B0); PG8_MMA(1, 1, At, B1); PG8_BAR; PG8_SCHED;
            } else {
            PG8_LDB(B0, 0, 0); PG8_SCHED; PG8_LDA(At, 0, 0); PG8_STAGE(PG8_SA(1, 1), a1 + hstepA, voffA);
            PG8_WAIT_L(8); PG8_BAR; PG8_WAIT_L(0); PG8_MMA(0, 0, At, B0); PG8_BAR; PG8_SCHED;
            PG8_LDB(B1, 0, 1); PG8_STAGE(PG8_SB(0, 0), b2, voffB);
            PG8_BAR; PG8_WAIT_L(0); PG8_MMA(0, 1, At, B1); PG8_BAR;
            PG8_LDA(At, 0, 1); PG8_STAGE(PG8_SA(0, 0), a2, voffA);
            PG8_BAR; PG8_WAIT_L(0); PG8_MMA(1, 0, At, B0); PG8_BAR; PG8_SCHED;
            PG8_STAGE(PG8_SB(0, 1), b2 + hstepB, voffB);
            PG8_WAIT_V(6); PG8_BAR; PG8_MMA(1, 1, At, B1); PG8_BAR;
            PG8_LDB(B0, 1, 0); PG8_SCHED; PG8_LDA(At, 1, 0); PG8_STAGE(PG8_SA(0, 1), a2 + hstepA, voffA);
            PG8_WAIT_L(8); PG8_BAR; PG8_WAIT_L(0); PG8_MMA(0, 0, At, B0); PG8_BAR; PG8_SCHED;
            PG8_LDB(B1, 1, 1); PG8_STAGE(PG8_SB(1, 0), b3, voffB);
            PG8_BAR; PG8_WAIT_L(0); PG8_MMA(0, 1, At, B1); PG8_BAR;
            PG8_LDA(At, 1, 1); PG8_STAGE(PG8_SA(1, 0), a3, voffA);
            PG8_BAR; PG8_WAIT_L(0); PG8_MMA(1, 0, At, B0); PG8_BAR; PG8_SCHED;
            PG8_STAGE(PG8_SB(1, 1), b3 + hstepB, voffB);
            PG8_WAIT_V(6); PG8_BAR; PG8_MMA(1, 1, At, B1); PG8_BAR;
            }
        }
        if constexpr (ALIGN_EPI) { if (wr == 0) PG8_BAR; }
        if constexpr (!Epi::AFTER_DRAIN) { E(acc, cur, wr, wc, fr, fq); S.done(cur); }
        if (!has_next) break;
#pragma unroll
        for (int a = 0; a < 2; ++a)
#pragma unroll
            for (int b = 0; b < 2; ++b)
#pragma unroll
                for (int m = 0; m < 4; ++m)
#pragma unroll
                    for (int n = 0; n < 2; ++n) acc[a][b][m][n] = (f32x4){0.f, 0.f, 0.f, 0.f};
        cur = nxt; cA = nA; cB = nB; ++ui;
        if constexpr (ALIGN_EPI) { if (wr == 1) PG8_BAR; }
    }
    PG8_WAIT_V(0);
    if constexpr (!ALIGN_EPI) { if (wr == 0) PG8_BAR; }
    PG8_BAR;
    if constexpr (Epi::AFTER_DRAIN) { E.fused(acc, cur, wr, wc, fr, fq, lds, wid, lane); S.done(cur); }
#undef PG8_SA
#undef PG8_SB
#undef PG8_STAGE
#undef PG8_LDA
#undef PG8_LDB
#undef PG8_MMA
#undef PG8_WAIT_V
#undef PG8_WAIT_L
#undef PG8_BAR
#undef PG8_SCHED
}
}
namespace mk {
constexpr int NWAVES = 8, NTHREADS = 512;
constexpr int D = 1024, NTOK = 16384, SEQ = 2048, NBATCH = 8;
constexpr float ALPHA = 1.41421356237f, LN_EPS = 1e-5f;
constexpr size_t MiB = 1u << 20;
constexpr size_t WS_CTL = 0, CTL_ZERO_BYTES = 1 * MiB;
constexpr size_t WS_WIN0 = 1 * MiB;
constexpr size_t WS_WMKV = 6 * MiB;
constexpr size_t WS_WIN1 = 7 * MiB;
constexpr size_t WS_WOUT = 11 * MiB;
constexpr size_t WS_WQKV = 15 * MiB;
constexpr size_t WS_MEMN = 16 * MiB;
constexpr size_t WS_MEMKV = 20 * MiB;
constexpr size_t WS_ROUTE = 22 * MiB;
constexpr size_t WS_WEXP = 26 * MiB;
constexpr size_t WS_XBF = 74 * MiB;
constexpr size_t WS_R1 = 106 * MiB;
constexpr size_t WS_R3 = 186 * MiB;
constexpr size_t WS_END = 258 * MiB;
constexpr int CW_BAR = 4096;
constexpr int LDS_BYTES = 163840, LDSCTL_OFF = LDS_BYTES - 512, MISC_OFF = LDSCTL_OFF + 320;

#define GAS __attribute__((address_space(1)))
#define LAS __attribute__((address_space(3)))
typedef unsigned short bf16;
typedef unsigned v4u __attribute__((ext_vector_type(4)));
typedef unsigned v2u __attribute__((ext_vector_type(2)));
typedef float f32x4 __attribute__((ext_vector_type(4)));
typedef short bf16x8 __attribute__((ext_vector_type(8)));
typedef GAS unsigned gu32;
#define RLX_AGENT __ATOMIC_RELAXED, __HIP_MEMORY_SCOPE_AGENT
#define LDS_WAIT() asm volatile("s_waitcnt lgkmcnt(0)" ::: "memory")
#define VM_WAIT() asm volatile("s_waitcnt vmcnt(0)" ::: "memory")
__device__ __forceinline__ unsigned f2bf(float f) { unsigned u = __builtin_bit_cast(unsigned, f); return (u + 0x7fffu + ((u >> 16) & 1u)) >> 16; }
__device__ __forceinline__ unsigned pk2(float lo, float hi) { return f2bf(lo) | (f2bf(hi) << 16); }
__device__ __forceinline__ float bf2f(unsigned short b) { return __builtin_bit_cast(float, (unsigned)b << 16); }
__device__ __forceinline__ float bflo(unsigned w) { return __builtin_bit_cast(float, w << 16); }
__device__ __forceinline__ float bfhi(unsigned w) { return __builtin_bit_cast(float, w & 0xffff0000u); }

#define XB_TMO      128
#define XB_XCNT(j)  (256  + 64 * (j))
#define XB_XSUB(j)  (1280 + 64 * (j))
#define XB_XGEN(j)  (2304 + 64 * (j))
#define XB_TOP      3328
#define XB_TOPGEN   3392
#define XCD_BAR_WORDS 3456
#define XB_SPIN_CAP (1u << 18)
__device__ __forceinline__ unsigned xb_ld(unsigned* p)              { return __hip_atomic_load(p, __ATOMIC_RELAXED, __HIP_MEMORY_SCOPE_AGENT); }
__device__ __forceinline__ unsigned xb_add(unsigned* p, unsigned v) { return __hip_atomic_fetch_add(p, v, __ATOMIC_RELAXED, __HIP_MEMORY_SCOPE_AGENT); }
__device__ __forceinline__ unsigned xb_xcc_id() { return (unsigned)__builtin_amdgcn_s_getreg((3 << 11) | 20) & 0xFu; }
#define XB_SPIN(cond, bar) do { unsigned _sp = 0; while (cond) { __builtin_amdgcn_s_sleep(1); \
    if ((++_sp & 255u) == 0u) { if (xb_ld(&(bar)[XB_TMO])) break; if (_sp > XB_SPIN_CAP) { atomicAdd(&(bar)[XB_TMO], 1u); break; } } } } while (0)
struct XcdBarrier { unsigned* bar; unsigned x; volatile LAS unsigned* st; };
__device__ __forceinline__ XcdBarrier xcd_barrier_post(unsigned* bar, volatile LAS unsigned* st) {
    XcdBarrier b; b.bar = bar; b.x = xb_xcc_id(); b.st = st;
    if (threadIdx.x == 0) (void)xb_add(&bar[XB_XCNT(b.x)], 1u);
    return b;
}
__device__ __forceinline__ void xcd_barrier_complete(unsigned* bar, unsigned x, unsigned& nloc, unsigned& nx) {
    const unsigned G = gridDim.x * gridDim.y * gridDim.z;
    unsigned sum, cnt, mine, sp = 0u;
    for (;;) {
        sum = 0u; cnt = 0u; mine = 0u;
#pragma unroll
        for (unsigned j = 0; j < 16; ++j) { const unsigned c = xb_ld(&bar[XB_XCNT(j)]); sum += c; cnt += (c > 0u) ? 1u : 0u; mine = (j == x) ? c : mine; }
        if (sum == G) break;
        __builtin_amdgcn_s_sleep(1);
        if ((++sp & 255u) == 0u) { if (xb_ld(&bar[XB_TMO])) break; if (sp > XB_SPIN_CAP) { atomicAdd(&bar[XB_TMO], 1u); break; } }
    }
    nloc = mine > 0u ? mine : 1u; nx = cnt > 0u ? cnt : 1u;
}
__device__ __forceinline__ void xcd_barrier(const XcdBarrier& b) {
    asm volatile("s_waitcnt vmcnt(0)" ::: "memory");
    __syncthreads();
    if (threadIdx.x == 0) {
        unsigned* bar = b.bar;
        __builtin_amdgcn_s_waitcnt(0);
        unsigned nloc = b.st[0], nx = b.st[1];
        if (nloc == 0u) { xcd_barrier_complete(bar, b.x, nloc, nx); b.st[0] = nloc; b.st[1] = nx; }
        const unsigned old = xb_add(&bar[XB_XSUB(b.x)], 1u);
        const unsigned gen = old / nloc;
        if (old + 1u == (gen + 1u) * nloc) {
            __builtin_amdgcn_fence(__ATOMIC_RELEASE, "agent");
            asm volatile("s_waitcnt vmcnt(0)" ::: "memory");
            const unsigned og = xb_add(&bar[XB_TOP], 1u);
            const unsigned tg = og / nx;
            if (og + 1u == (tg + 1u) * nx) xb_add(&bar[XB_TOPGEN], 1u);
            else XB_SPIN(xb_ld(&bar[XB_TOPGEN]) == tg, bar);
            __builtin_amdgcn_fence(__ATOMIC_ACQUIRE, "agent");
            xb_add(&bar[XB_XGEN(b.x)], 1u);
            asm volatile("s_waitcnt vmcnt(0)" ::: "memory");
        } else {
            XB_SPIN(xb_ld(&bar[XB_XGEN(b.x)]) == gen, bar);
            __builtin_amdgcn_fence(__ATOMIC_ACQUIRE, "agent");
            asm volatile("s_waitcnt vmcnt(0)" ::: "memory");
        }
    }
    __syncthreads();
}

struct Args { const float* in[22]; float* out; unsigned char* ws; int ph_lo, ph_hi, li, pad; };
struct Frame {
    LAS unsigned char* lds; volatile LAS unsigned* MISC; gu32* ctl;
    int tid, lane, wave, vcu, G;
};
__device__ __forceinline__ float wave_sum(float v) {
#pragma unroll
    for (int o = 1; o < 64; o <<= 1) v += __shfl_xor(v, o);
    return v;
}

__device__ __forceinline__ void p0_tr_item(const float* W, int ldw, int col0, bf16* WT, int K, int drow0, float scale, LAS float* scr, int kb, int nb, int lane) {
    const int k0 = 64 * kb, n0 = 32 * nb;
#pragma unroll 8
    for (int i = 0; i < 32; ++i) { const int kk = 2 * i + (lane >> 5); scr[kk * 33 + (lane & 31)] = W[(size_t)(k0 + kk) * ldw + col0 + n0 + (lane & 31)] * scale; }
    LDS_WAIT(); asm volatile("" ::: "memory");
    const int c = lane & 7;
#pragma unroll
    for (int j = 0; j < 4; ++j) { const int n = (lane >> 3) + 8 * j; const LAS float* s = scr + (8 * c) * 33 + n;
        v4u o; o.x = pk2(s[0 * 33], s[1 * 33]); o.y = pk2(s[2 * 33], s[3 * 33]); o.z = pk2(s[4 * 33], s[5 * 33]); o.w = pk2(s[6 * 33], s[7 * 33]);
        *(GAS v4u*)(WT + (size_t)(drow0 + n0 + n) * K + k0 + 8 * c) = o; }
    LDS_WAIT(); asm volatile("" ::: "memory");
}
__device__ __forceinline__ bool p0_seg(int& it, const float* W, int ldw, int col0, int ncols, int K, bf16* WT, int drow0, float scale, LAS float* scr, int lane) {
    const int nblk = ncols / 32, items = (K / 64) * nblk;
    if (it < items) { p0_tr_item(W, ldw, col0, WT, K, drow0, scale, scr, it / nblk, it % nblk, lane); return true; }
    it -= items; return false;
}
__device__ __forceinline__ void p0_experts(const Frame& F, const float* wg, const float* wu, const float* wd, bf16* WGU, bf16* WD, int gw0, int ngw) {
    LAS float* scr = (LAS float*)(F.lds + F.wave * 16384);
    constexpr int I_GU = 16 * 16, I_D = 8 * 32;
    constexpr int PER_E = 2 * I_GU + I_D, TOTAL = 16 * PER_E;
    for (int it = gw0; it < TOTAL; it += ngw) {
        const int e = it / PER_E; int r = it % PER_E;
        if (r < 2 * I_GU) {
            const int up = r / I_GU; r %= I_GU; const int kb = r / 16, nb = r % 16;
            const float* src = (up ? wu : wg) + (size_t)e * 1024 * 512;
            const int c0 = nb * 32, drow = (c0 / 128) * 256 + up * 128 + (c0 % 128);
            p0_tr_item(src, 512, c0, WGU + (size_t)e * 1024 * 1024, 1024, drow, 1.f, scr, kb, 0, F.lane);
        } else {
            r -= 2 * I_GU; const int kb = r / 32, nb = r % 32;
            p0_tr_item(wd + (size_t)e * 512 * 1024, 1024, 0, WD + (size_t)e * 1024 * 512, 512, 0, 1.f, scr, kb, nb, F.lane);
        }
    }
}
__device__ __forceinline__ void p0_prologue(const Frame& F, const Args& a) {
    unsigned char* ws = a.ws;
    LAS float* scr = (LAS float*)(F.lds + F.wave * 16384);
    const int gw = F.vcu * NWAVES + F.wave, NGW = F.G * NWAVES;
    bf16* WIN0 = (bf16*)(ws + WS_WIN0); bf16* WMKV = (bf16*)(ws + WS_WMKV); bf16* WIN1 = (bf16*)(ws + WS_WIN1); bf16* WOUT = (bf16*)(ws + WS_WOUT); bf16* WQKV = (bf16*)(ws + WS_WQKV);
    const float* na_w_in = a.in[7]; const float* w_mem_kv = a.in[4]; const float* ml_w_in = a.in[9]; const float* w_out = a.in[16]; const float* w_qkv = a.in[12];
    constexpr int N_MISC = 16 * (80 + 16 + 56 + 64) + 12 * 18;
    for (int it0 = gw; it0 < N_MISC; it0 += NGW) {
        int it = it0;
        if (p0_seg(it, na_w_in, 2560, 0, 768, 1024, WIN0, 0, 0.125f, scr, F.lane)) continue;
        if (p0_seg(it, na_w_in, 2560, 2304, 256, 1024, WIN0, 768, 0.125f, scr, F.lane)) continue;
        if (p0_seg(it, na_w_in, 2560, 768, 768, 1024, WIN0, 1024, 1.f, scr, F.lane)) continue;
        if (p0_seg(it, na_w_in, 2560, 1536, 768, 1024, WIN0, 1792, 1.f, scr, F.lane)) continue;
        if (p0_seg(it, w_mem_kv, 512, 0, 512, 1024, WMKV, 0, 1.f, scr, F.lane)) continue;
        if (p0_seg(it, ml_w_in, 1808, 0, 768, 1024, WIN1, 0, 1.f, scr, F.lane)) continue;
        if (p0_seg(it, ml_w_in, 1808, 1552, 256, 1024, WIN1, 768, 0.125f, scr, F.lane)) continue;
        if (p0_seg(it, ml_w_in, 1808, 768, 768, 1024, WIN1, 1024, 1.f, scr, F.lane)) continue;
        if (p0_seg(it, w_out, 1024, 0, 1024, 1024, WOUT, 0, 1.f, scr, F.lane)) continue;
        if (p0_seg(it, w_out + (size_t)1024 * 1024, 1024, 0, 1024, 1024, WOUT + (size_t)1024 * 1024, 0, 1.f, scr, F.lane)) continue;
        { const int m = it / 18, r = it % 18; const int mat = m / 4;
          p0_tr_item(w_qkv + (size_t)m * 192 * 192, 192, 0, WQKV + (size_t)m * 192 * 192, 192, 0, mat == 1 ? 0.07216878364870322f : 1.f, scr, r / 6, r % 6, F.lane); }
    }
    p0_experts(F, a.in[19], a.in[20], a.in[21], (bf16*)(ws + WS_WEXP), (bf16*)(ws + WS_WEXP + 32 * MiB), gw, NGW);
    const float* x = a.in[0]; bf16* XBF = (bf16*)(ws + WS_XBF);
    for (int m = gw; m < NTOK; m += NGW) {
        const GAS f32x4* xr = (const GAS f32x4*)(x + (size_t)m * D) + F.lane; GAS unsigned long long* o8 = (GAS unsigned long long*)(XBF + (size_t)m * D) + F.lane;
#pragma unroll
        for (int j = 0; j < 4; ++j) { const f32x4 v = xr[64 * j]; o8[64 * j] = (unsigned long long)pk2(v.x, v.y) | ((unsigned long long)pk2(v.z, v.w) << 32); }
    }
    const float* mem = a.in[1]; const float* mg = a.in[2]; const float* mb = a.in[3]; bf16* MEMN = (bf16*)(ws + WS_MEMN);
    for (int m = gw; m < 2048; m += NGW) {
        const GAS f32x4* xr = (const GAS f32x4*)(mem + (size_t)m * D) + F.lane;
        f32x4 v[4]; float s = 0.f;
#pragma unroll
        for (int j = 0; j < 4; ++j) { v[j] = xr[64 * j]; s += (v[j].x + v[j].y) + (v[j].z + v[j].w); }
        const float mean = wave_sum(s) * (1.f / D); float s2 = 0.f;
#pragma unroll
        for (int j = 0; j < 4; ++j) { v[j] = v[j] - mean; s2 += (v[j].x * v[j].x + v[j].y * v[j].y) + (v[j].z * v[j].z + v[j].w * v[j].w); }
        const float rstd = 1.f / sqrtf(wave_sum(s2) * (1.f / D) + LN_EPS);
        GAS unsigned long long* o8 = (GAS unsigned long long*)(MEMN + (size_t)m * D) + F.lane;
#pragma unroll
        for (int j = 0; j < 4; ++j) { const f32x4 g = ((const GAS f32x4*)mg)[F.lane + 64 * j], b = ((const GAS f32x4*)mb)[F.lane + 64 * j]; const f32x4 o = v[j] * rstd * g + b;
            o8[64 * j] = (unsigned long long)pk2(o.x, o.y) | ((unsigned long long)pk2(o.z, o.w) << 32); }
    }
}

typedef float f32x2_t __attribute__((ext_vector_type(2)));
typedef __bf16 bf16x2_t __attribute__((ext_vector_type(2)));
typedef short s16x4 __attribute__((ext_vector_type(4)));
__device__ __forceinline__ unsigned cvtpk(float lo, float hi) { f32x2_t v = {lo, hi}; bf16x2_t b = __builtin_convertvector(v, bf16x2_t); return __builtin_bit_cast(unsigned, b); }
#define MFMA16(a, b, c) __builtin_amdgcn_mfma_f32_16x16x32_bf16((a), (b), (c), 0, 0, 0)

template <bool NA>
__device__ __forceinline__ void attn16(LAS const unsigned char* lds, const int (&kofs)[8], const int (&vofs)[8], int vpitch, const bf16x8 (&qf)[2], int cq, int g, int swz,
                                       LAS const float* tab, const int (&drow)[8], const int (&dcb)[2][4], unsigned vmask, f32x4 (&o)[4], float& linv) {
    f32x4 s[8][2];
    const int c0 = (g ^ swz) << 4, c1 = ((g + 4) ^ swz) << 4;
#pragma unroll
    for (int kg = 0; kg < 8; ++kg)
#pragma unroll
        for (int t = 0; t < 2; ++t) {
            const int ra = kofs[kg] + (16 * t + cq) * 128;
            const bf16x8 k0 = *(LAS const bf16x8*)(lds + ra + c0), k1 = *(LAS const bf16x8*)(lds + ra + c1);
            f32x4 z = {0.f, 0.f, 0.f, 0.f};
            z = MFMA16(k0, qf[0], z); s[kg][t] = MFMA16(k1, qf[1], z);
        }
    float m = -1e30f;
#pragma unroll
    for (int kg = 0; kg < 8; ++kg)
#pragma unroll
        for (int t = 0; t < 2; ++t)
#pragma unroll
            for (int i = 0; i < 4; ++i) {
                float v = s[kg][t][i];
                if (NA) { v += tab[drow[kg] + dcb[t][i]]; v = ((vmask >> (t * 4 + i)) & 1u) ? v : -1e30f; }
                s[kg][t][i] = v; m = fmaxf(m, v);
            }
    m = fmaxf(m, __shfl_xor(m, 16)); m = fmaxf(m, __shfl_xor(m, 32));
    float l = 0.f;
#pragma unroll
    for (int kg = 0; kg < 8; ++kg)
#pragma unroll
        for (int t = 0; t < 2; ++t)
#pragma unroll
            for (int i = 0; i < 4; ++i) { const float p = __expf(s[kg][t][i] - m); s[kg][t][i] = p; l += p; }
    l += __shfl_xor(l, 16); l += __shfl_xor(l, 32);
    linv = 1.f / l;
#pragma unroll
    for (int dt = 0; dt < 4; ++dt) o[dt] = (f32x4){0.f, 0.f, 0.f, 0.f};
#pragma unroll
    for (int kg = 0; kg < 8; ++kg) {
        v4u pw; pw.x = cvtpk(s[kg][0][0], s[kg][0][1]); pw.y = cvtpk(s[kg][0][2], s[kg][0][3]); pw.z = cvtpk(s[kg][1][0], s[kg][1][1]); pw.w = cvtpk(s[kg][1][2], s[kg][1][3]);
        const bf16x8 pf = __builtin_bit_cast(bf16x8, pw);
#pragma unroll
        for (int dt = 0; dt < 4; ++dt) {
            const int va = vofs[kg] + (16 * dt + cq) * vpitch + 8 * g;
            const s16x4 lo = *(LAS const s16x4*)(lds + va), hi = *(LAS const s16x4*)(lds + va + 32);
            const bf16x8 vf = __builtin_shufflevector(lo, hi, 0, 1, 2, 3, 4, 5, 6, 7);
            o[dt] = MFMA16(vf, pf, o[dt]);
        }
    }
}
__device__ __forceinline__ void attn_store(bf16* dst  , const f32x4 (&o)[4], float linv, int g) {
#pragma unroll
    for (int dt = 0; dt < 4; ++dt) { v2u w; w.x = cvtpk(o[dt][0] * linv, o[dt][1] * linv); w.y = cvtpk(o[dt][2] * linv, o[dt][3] * linv); *(GAS v2u*)(dst + 16 * dt + 4 * g) = w; }
}

constexpr int NA_KR = 0, NA_VR = 9 * 8192, NA_VSLOT = 64 * 136, NA_TAB = NA_VR + 9 * NA_VSLOT;
static_assert(NA_TAB + 2048 <= LDSCTL_OFF, "NA LDS map");
__device__ __forceinline__ int na_rs(int r) { return min(max(r - 4, 0), 24); }
__device__ __forceinline__ void na_row_write(const Frame& F, int R, v4u kv, v4u vv) {
    const int col = F.tid >> 3, chunk = F.tid & 7, slot = R % 9;
    *(LAS v4u*)(F.lds + NA_KR + slot * 8192 + col * 128 + ((chunk ^ (col & 7)) << 4)) = kv;
    LAS unsigned short* vt = (LAS unsigned short*)(F.lds + NA_VR + slot * NA_VSLOT) + (chunk * 8) * 68 + col;
    vt[0 * 68] = (unsigned short)(vv.x & 0xffff); vt[1 * 68] = (unsigned short)(vv.x >> 16); vt[2 * 68] = (unsigned short)(vv.y & 0xffff); vt[3 * 68] = (unsigned short)(vv.y >> 16);
    vt[4 * 68] = (unsigned short)(vv.z & 0xffff); vt[5 * 68] = (unsigned short)(vv.z >> 16); vt[6 * 68] = (unsigned short)(vv.w & 0xffff); vt[7 * 68] = (unsigned short)(vv.w >> 16);
}
__device__ __forceinline__ void na_item(const Frame& F, bf16* H0, const float* rpb, int b, int h, int half) {
    const int cq = F.lane & 15, g = F.lane >> 4, j = F.wave & 3, wrow = F.wave >> 2;
    LAS float* tab = (LAS float*)(F.lds + NA_TAB);
    if (F.tid < 465) tab[F.tid] = rpb[h * 465 + F.tid];
    const int col = F.tid >> 3, chunk = F.tid & 7;
    const bf16* kvsrc = H0 + (size_t)(b * 2048 + col) * 2560 + 1024 + h * 64 + chunk * 8;
    const int r0 = 16 * half;
    int hi = na_rs(r0 + 1) + 7;
    for (int R = na_rs(r0); R <= hi; ++R) {
        const v4u kv = *(const GAS v4u*)(kvsrc + (size_t)R * 64 * 2560), vv = *(const GAS v4u*)(kvsrc + (size_t)R * 64 * 2560 + 768);
        na_row_write(F, R, kv, vv);
    }
    __syncthreads();
    const int cb = min(max(16 * j - 8, 0), 32), c = 16 * j + cq, cs = min(max(c - 8, 0), 48);
    int dcb[2][4]; unsigned vmask = 0u;
#pragma unroll
    for (int t = 0; t < 2; ++t)
#pragma unroll
        for (int i = 0; i < 4; ++i) { const int kc = cb + 16 * t + 4 * g + i; if (kc >= cs && kc < cs + 16) vmask |= 1u << (t * 4 + i); dcb[t][i] = min(max(kc - c + 15, 0), 30); }
    const int swz = (cb + cq) & 7;
    for (int p = 0; p < 8; ++p) {
        const int ra = r0 + 2 * p, r = ra + wrow;
        const int hi_next = (p < 7) ? na_rs(ra + 3) + 7 : hi, nnew = hi_next - hi;
        v4u pk0, pv0, pk1, pv1;
        if (nnew >= 1) { pk0 = *(const GAS v4u*)(kvsrc + (size_t)(hi + 1) * 64 * 2560); pv0 = *(const GAS v4u*)(kvsrc + (size_t)(hi + 1) * 64 * 2560 + 768); }
        if (nnew >= 2) { pk1 = *(const GAS v4u*)(kvsrc + (size_t)(hi + 2) * 64 * 2560); pv1 = *(const GAS v4u*)(kvsrc + (size_t)(hi + 2) * 64 * 2560 + 768); }
        {
            const int rsr = na_rs(r);
            int kofs[8], vofs[8], drow[8];
#pragma unroll
            for (int kr = 0; kr < 8; ++kr) { const int R = rsr + kr, slot = R % 9; kofs[kr] = NA_KR + slot * 8192 + cb * 128; vofs[kr] = NA_VR + slot * NA_VSLOT + cb * 2; drow[kr] = (R - r + 7) * 31; }
            bf16* qrow = H0 + (size_t)(b * 2048 + r * 64 + 16 * j + cq) * 2560 + h * 64;
            bf16x8 qf[2]; qf[0] = *(const GAS bf16x8*)(qrow + 8 * g); qf[1] = *(const GAS bf16x8*)(qrow + 32 + 8 * g);
            f32x4 o[4]; float linv;
            attn16<true>(F.lds, kofs, vofs, 136, qf, cq, g, swz, tab, drow, dcb, vmask, o, linv);
            attn_store(qrow, o, linv, g);
        }
        __syncthreads();
        if (nnew >= 1) na_row_write(F, hi + 1, pk0, pv0);
        if (nnew >= 2) na_row_write(F, hi + 2, pk1, pv1);
        hi = hi_next;
        __syncthreads();
    }
}
constexpr int MA_K = 0, MA_V = 32768, MA_VP = 520;
__device__ __forceinline__ void memattn_unit(const Frame& F, bf16* Hq, int ld, int qcol, const bf16* memkv, int b, int h, int tok0, int ntok) {
    const int cq = F.lane & 15, g = F.lane >> 4;
#pragma unroll
    for (int i = 0; i < 4; ++i) {
        const int pce = F.tid + 512 * i, key = pce >> 3, chunk = pce & 7;
        const bf16* src = memkv + (size_t)(b * 256 + key) * 512 + h * 64 + chunk * 8;
        const v4u kv = *(const GAS v4u*)src, vv = *(const GAS v4u*)(src + 256);
        *(LAS v4u*)(F.lds + MA_K + key * 128 + ((chunk ^ (key & 7)) << 4)) = kv;
        LAS unsigned short* vt = (LAS unsigned short*)(F.lds + MA_V) + (chunk * 8) * 260 + key;
        vt[0 * 260] = (unsigned short)(vv.x & 0xffff); vt[1 * 260] = (unsigned short)(vv.x >> 16); vt[2 * 260] = (unsigned short)(vv.y & 0xffff); vt[3 * 260] = (unsigned short)(vv.y >> 16);
        vt[4 * 260] = (unsigned short)(vv.z & 0xffff); vt[5 * 260] = (unsigned short)(vv.z >> 16); vt[6 * 260] = (unsigned short)(vv.w & 0xffff); vt[7 * 260] = (unsigned short)(vv.w >> 16);
    }
    __syncthreads();
    int kofs[8], vofs[8], drow[8]; int dcb[2][4];
#pragma unroll
    for (int kg = 0; kg < 8; ++kg) { kofs[kg] = MA_K + kg * 4096; vofs[kg] = MA_V + kg * 64; drow[kg] = 0; }
#pragma unroll
    for (int t = 0; t < 2; ++t)
#pragma unroll
        for (int i = 0; i < 4; ++i) dcb[t][i] = 0;
    for (int blk = F.wave; blk < ntok / 16; blk += NWAVES) {
        asm volatile("" ::: "memory");
        bf16* qrow = Hq + (size_t)(tok0 + blk * 16 + cq) * ld + qcol + h * 64;
        bf16x8 qf[2]; qf[0] = *(const GAS bf16x8*)(qrow + 8 * g); qf[1] = *(const GAS bf16x8*)(qrow + 32 + 8 * g);
        f32x4 o[4]; float linv;
        attn16<false>(F.lds, kofs, vofs, MA_VP, qf, cq, g, cq & 7, nullptr, drow, dcb, 0u, o, linv);
        attn_store(qrow, o, linv, g);
    }
    __syncthreads();
}
__device__ __forceinline__ void p2_attention(const Frame& F, const Args& a) {
    bf16* H0 = (bf16*)(a.ws + WS_R1); const bf16* memkv = (const bf16*)(a.ws + WS_MEMKV);
    for (int L = blockIdx.x; L < 256; L += gridDim.x) {
        if (L < 192) na_item(F, H0, a.in[8], L / 24, (L % 24) >> 1, L & 1);
        else { const int su = L - 192; memattn_unit(F, H0, 2560, 768, memkv, su >> 3, (su & 7) >> 1, (su >> 3) * 2048 + (su & 1) * 1024, 1024); }
        __syncthreads();
    }
}
constexpr int CW_CNT = 8192;
constexpr size_t RT_TOK = 0, RT_SEL = 1 * MiB, RT_GATES = 2 * MiB;
constexpr int SLOT_ROWS = 36864;

__device__ __forceinline__ float reduce16(float (&a)[16], int lane) {
    const bool b5 = lane & 32, b4 = lane & 16, b3 = lane & 8, b2 = lane & 4;
    float r8[8], r4[4], r2[2];
#pragma unroll
    for (int i = 0; i < 8; ++i) { const float keep = b5 ? a[i + 8] : a[i], send = b5 ? a[i] : a[i + 8]; r8[i] = keep + __shfl_xor(send, 32); }
#pragma unroll
    for (int i = 0; i < 4; ++i) { const float keep = b4 ? r8[i + 4] : r8[i], send = b4 ? r8[i] : r8[i + 4]; r4[i] = keep + __shfl_xor(send, 16); }
#pragma unroll
    for (int i = 0; i < 2; ++i) { const float keep = b3 ? r4[i + 2] : r4[i], send = b3 ? r4[i] : r4[i + 2]; r2[i] = keep + __shfl_xor(send, 8); }
    float r = (b2 ? r2[1] : r2[0]) + __shfl_xor(b2 ? r2[0] : r2[1], 4);
    r += __shfl_xor(r, 2); r += __shfl_xor(r, 1);
    return r;
}
__device__ __forceinline__ void stage_proj16(const Frame& F, const float* W, int ldw, int off) {
    LAS f32x4* dst = (LAS f32x4*)(F.lds + off);
    for (int i = F.tid; i < 1024 * 4; i += NTHREADS) dst[i] = *(const GAS f32x4*)(W + (size_t)(i >> 2) * ldw + (i & 3) * 4);
}
__device__ __forceinline__ float proj16(const Frame& F, const f32x4 (&v)[4], int off) {
    const LAS f32x4* w = (const LAS f32x4*)(F.lds + off);
    float acc[16];
#pragma unroll
    for (int e = 0; e < 16; ++e) acc[e] = 0.f;
#pragma unroll
    for (int j = 0; j < 4; ++j) {
        asm volatile("" ::: "memory");
#pragma unroll
        for (int i = 0; i < 4; ++i) {
            const int c = 4 * F.lane + 256 * j + i; const float xv = v[j][i];
#pragma unroll
            for (int q = 0; q < 4; ++q) { const f32x4 r = w[c * 4 + q]; acc[4 * q] += xv * r.x; acc[4 * q + 1] += xv * r.y; acc[4 * q + 2] += xv * r.z; acc[4 * q + 3] += xv * r.w; }
        }
    }
    return reduce16(acc, F.lane);
}
__device__ __forceinline__ void ln_row(const Frame& F, f32x4 (&v)[4], const float* g, const float* b) {
    float s = 0.f;
#pragma unroll
    for (int j = 0; j < 4; ++j) s += (v[j].x + v[j].y) + (v[j].z + v[j].w);
    const float mean = wave_sum(s) * (1.f / D); float s2 = 0.f;
#pragma unroll
    for (int j = 0; j < 4; ++j) { v[j] = v[j] - mean; s2 += (v[j].x * v[j].x + v[j].y * v[j].y) + (v[j].z * v[j].z + v[j].w * v[j].w); }
    const float rstd = 1.f / sqrtf(wave_sum(s2) * (1.f / D) + LN_EPS);
#pragma unroll
    for (int j = 0; j < 4; ++j) { const f32x4 gg = ((const GAS f32x4*)g)[F.lane + 64 * j], bb = ((const GAS f32x4*)b)[F.lane + 64 * j]; v[j] = v[j] * rstd * gg + bb; }
}
__device__ __forceinline__ void store_row_f32_bf16(const Frame& F, const f32x4 (&v)[4], float* xo, bf16* xb) {
#pragma unroll
    for (int j = 0; j < 4; ++j) { ((GAS f32x4*)xo)[F.lane + 64 * j] = v[j];
        ((GAS unsigned long long*)xb)[F.lane + 64 * j] = (unsigned long long)pk2(v[j].x, v[j].y) | ((unsigned long long)pk2(v[j].z, v[j].w) << 32); }
}
__device__ __forceinline__ f32x4 bf4_to_f32(unsigned long long w) { return (f32x4){bflo((unsigned)w), bfhi((unsigned)w), bflo((unsigned)(w >> 32)), bfhi((unsigned)(w >> 32))}; }

constexpr int P4_W = 0, P4_LG = 65536;
__device__ __forceinline__ void p4_ln_route(const Frame& F, const Args& a, int layer, const float* xres, float* xout) {
    unsigned char* ws = a.ws;
    const bf16* T = (const bf16*)(ws + WS_R3); bf16* XBF = (bf16*)(ws + WS_XBF);
    const float* g = a.in[17] + (layer * 2) * 1024; const float* bb = a.in[18] + (layer * 2) * 1024;
    int* tokmap = (int*)(ws + WS_ROUTE + RT_TOK); int* sel = (int*)(ws + WS_ROUTE + RT_SEL);
    gu32* cnt = F.ctl + CW_CNT + 64 * layer;
    stage_proj16(F, a.in[5], 16, P4_W);
    __syncthreads();
    LAS float* lg = (LAS float*)(F.lds + P4_LG);
    for (int grp = blockIdx.x; grp < NTOK / 64; grp += gridDim.x) {
        for (int tt = 0; tt < 8; ++tt) {
            const int slot = F.wave * 8 + tt, t = grp * 64 + slot;
            f32x4 v[4];
#pragma unroll
            for (int j = 0; j < 4; ++j) { const f32x4 xr = ((const GAS f32x4*)(xres + (size_t)t * D))[F.lane + 64 * j];
                const f32x4 tv = bf4_to_f32(((const GAS unsigned long long*)(T + (size_t)t * D))[F.lane + 64 * j]); v[j] = xr * ALPHA + tv; }
            ln_row(F, v, g, bb);
            store_row_f32_bf16(F, v, xout + (size_t)t * D, XBF + (size_t)t * D);
            const float lgt = proj16(F, v, P4_W);
            if ((F.lane & 3) == 0) lg[slot * 16 + (F.lane >> 2)] = lgt;
        }
        __syncthreads();
        if (F.wave == 0) {
            const int t = grp * 64 + F.lane;
            const float* rb = a.in[6];
            float bestg = -1e30f; int bi1 = 0, bi2 = 1; float bs1 = 0.f, bs2 = 0.f;
#pragma unroll
            for (int gq = 0; gq < 4; ++gq) {
                const f32x4 l4 = *(const LAS f32x4*)(lg + F.lane * 16 + gq * 4);
                float v1 = -1e30f, v2 = -1e30f, s1 = 0.f, s2 = 0.f; int i1 = 0, i2 = 0;
#pragma unroll
                for (int j = 0; j < 4; ++j) {
                    const int e = gq * 4 + j; const float sc = 1.f / (1.f + expf(-l4[j])); const float bv = sc + rb[e];
                    if (bv > v1) { v2 = v1; i2 = i1; s2 = s1; v1 = bv; i1 = e; s1 = sc; } else if (bv > v2) { v2 = bv; i2 = e; s2 = sc; }
                }
                const float gs = v1 + v2;
                if (gs > bestg) { bestg = gs; bi1 = i1; bi2 = i2; bs1 = s1; bs2 = s2; }
            }
            const float inv = 1.f / (bs1 + bs2);
            unsigned mycnt = 0u; int p1 = 0, p2 = 0;
#pragma unroll
            for (int e = 0; e < 16; ++e) {
                const unsigned long long mk_ = __ballot(bi1 == e || bi2 == e); const unsigned c = (unsigned)__popcll(mk_);
                if (F.lane == e) mycnt = c;
                const int pre = __popcll(mk_ & ((1ull << F.lane) - 1ull));
                if (bi1 == e) p1 = pre; if (bi2 == e) p2 = pre;
            }
            unsigned base = 0u;
            if (F.lane < 16 && mycnt) base = __hip_atomic_fetch_add(cnt + F.lane, mycnt, RLX_AGENT);
            p1 += (int)__shfl(base, bi1); p2 += (int)__shfl(base, bi2);
            tokmap[bi1 * NTOK + p1] = t; tokmap[bi2 * NTOK + p2] = t;
            GAS int* s8 = (GAS int*)(sel + (size_t)t * 8);
            *(GAS v4u*)s8 = (v4u){(unsigned)bi1, (unsigned)p1, (unsigned)bi2, (unsigned)p2};
            *(GAS v2u*)(s8 + 4) = (v2u){__builtin_bit_cast(unsigned, bs1 * inv), __builtin_bit_cast(unsigned, bs2 * inv)};
        }
        __syncthreads();
    }
}
__device__ __forceinline__ void slot_offsets(const Frame& F, int layer) {
    __syncthreads();
    if (F.tid == 0) { gu32* cnt = F.ctl + CW_CNT + 64 * layer; int o = 0;
        for (int e = 0; e < 16; ++e) { const int c = (int)__hip_atomic_load(cnt + e, RLX_AGENT); F.MISC[32 + e] = (unsigned)c; F.MISC[16 + e] = (unsigned)o; o += ((c + 255) >> 8) << 8; } }
    __syncthreads();
}
__device__ __forceinline__ int slot_off(const Frame& F, int e) { return (int)F.MISC[16 + e]; }
__device__ __forceinline__ int slot_cnt(const Frame& F, int e) { return (int)F.MISC[32 + e]; }
__device__ __forceinline__ void p4b_scatter(const Frame& F, const Args& a, int layer) {
    unsigned char* ws = a.ws; const bf16* XBF = (const bf16*)(ws + WS_XBF); bf16* XG = (bf16*)(ws + WS_R3); const int* sel = (const int*)(ws + WS_ROUTE + RT_SEL);
    slot_offsets(F, layer);
    const int gw = blockIdx.x * NWAVES + F.wave, NGW = gridDim.x * NWAVES;
    for (int t = gw; t < NTOK; t += NGW) {
        const v4u s = *(const GAS v4u*)(sel + (size_t)t * 8);
        const int s0 = slot_off(F, (int)s.x) + (int)s.y, s1 = slot_off(F, (int)s.z) + (int)s.w;
        const GAS v4u* src = (const GAS v4u*)(XBF + (size_t)t * D) + F.lane; const v4u r0 = src[0], r1 = src[64];
        GAS v4u* d0 = (GAS v4u*)(XG + (size_t)s0 * D) + F.lane; GAS v4u* d1 = (GAS v4u*)(XG + (size_t)s1 * D) + F.lane;
        d0[0] = r0; d0[64] = r1; d1[0] = r0; d1[64] = r1;
    }
}
__device__ __forceinline__ void p7_combine_ln(const Frame& F, const Args& a, int layer, float* xio) {
    unsigned char* ws = a.ws; const bf16* Y = (const bf16*)(ws + WS_R3); bf16* XBF = (bf16*)(ws + WS_XBF); const int* sel = (const int*)(ws + WS_ROUTE + RT_SEL);
    float* gates = (float*)(ws + WS_ROUTE + RT_GATES);
    const float* g = a.in[17] + (layer * 2 + 1) * 1024; const float* bb = a.in[18] + (layer * 2 + 1) * 1024;
    slot_offsets(F, layer);
    if (layer == 0) { stage_proj16(F, a.in[9] + 1536, 1808, P4_W); __syncthreads(); }
    const int gw = blockIdx.x * NWAVES + F.wave, NGW = gridDim.x * NWAVES;
#pragma unroll 1
    for (int t = gw; t < NTOK; t += NGW) {
        const v4u s = *(const GAS v4u*)(sel + (size_t)t * 8); const f32x2_t wf = *(const GAS f32x2_t*)(sel + (size_t)t * 8 + 4);
        const float w0 = wf.x, w1 = wf.y;
        const int s0 = slot_off(F, (int)s.x) + (int)s.y, s1 = slot_off(F, (int)s.z) + (int)s.w;
        f32x4 v[4];
#pragma unroll
        for (int j = 0; j < 4; ++j) { const f32x4 xr = ((const GAS f32x4*)(xio + (size_t)t * D))[F.lane + 64 * j];
            const f32x4 y0 = bf4_to_f32(((const GAS unsigned long long*)(Y + (size_t)s0 * D))[F.lane + 64 * j]), y1 = bf4_to_f32(((const GAS unsigned long long*)(Y + (size_t)s1 * D))[F.lane + 64 * j]);
            v[j] = xr * ALPHA + y0 * w0 + y1 * w1; }
        ln_row(F, v, g, bb);
        store_row_f32_bf16(F, v, xio + (size_t)t * D, XBF + (size_t)t * D);
        if (layer == 0) { const float gt = proj16(F, v, P4_W); if ((F.lane & 3) == 0) gates[(size_t)t * 16 + (F.lane >> 2)] = gt + a.in[13][F.lane >> 2]; }
    }
}
struct MoeSched {
    const char* A; const char* B; size_t tA, tB, eB;
    int x, local, nloc;
    int nb0, nb1, rb0, rb1;
    __device__ __forceinline__ bool next(int i, pg8::Unit& u) const {
        const int q = i * nloc + local; if (q >= 4 * (nb0 + nb1)) return false;
        if (q < 4 * nb0) { u.g = x; u.pm = rb0 + (q >> 2); u.pn = q & 3; } else { const int q1 = q - 4 * nb0; u.g = x + 8; u.pm = rb1 + (q1 >> 2); u.pn = q1 & 3; }
        return true;
    }
    __device__ __forceinline__ const char* a_ptr(const pg8::Unit& u) const { return A + (size_t)u.pm * tA; }
    __device__ __forceinline__ const char* b_ptr(const pg8::Unit& u) const { return B + (size_t)u.g * eB + (size_t)u.pn * tB; }
    __device__ __forceinline__ void a_ready(const pg8::Unit&) const {}
    __device__ __forceinline__ void done(const pg8::Unit&) const {}
};
__device__ __forceinline__ MoeSched make_moe_sched(const Frame& F, int layer, const char* A, size_t tA, const char* B, size_t tB, size_t eB) {
    slot_offsets(F, layer);
    MoeSched S; S.A = A; S.B = B; S.tA = tA; S.tB = tB; S.eB = eB;
    S.x = blockIdx.x & 7; S.local = blockIdx.x >> 3; S.nloc = gridDim.x >> 3;
    S.nb0 = (slot_cnt(F, S.x) + 255) >> 8; S.nb1 = (slot_cnt(F, S.x + 8) + 255) >> 8; S.rb0 = slot_off(F, S.x) >> 8; S.rb1 = slot_off(F, S.x + 8) >> 8;
    return S;
}
struct EpiSwiGLU {
    static constexpr bool PERM = true, AFTER_DRAIN = false;
    pg8::bf16_t* HM;
    __device__ __forceinline__ void operator()(const pg8::f32x4 (&acc)[2][2][4][2], const pg8::Unit& u, int wr, int wc, int fr, int fq) const {
        const int row0 = u.pm * 256 + wr * 64 + fr, col0 = u.pn * 128 + wc * 32 + 8 * fq;
#pragma unroll
        for (int ai = 0; ai < 2; ++ai)
#pragma unroll
            for (int m = 0; m < 4; ++m) {
                float hv[8];
#pragma unroll
                for (int n = 0; n < 2; ++n)
#pragma unroll
                    for (int i = 0; i < 4; ++i) { const float gt = acc[ai][0][m][n][i], up = acc[ai][1][m][n][i]; hv[4 * n + i] = gt / (1.f + __expf(-gt)) * up; }
                pg8::u32x4 w; w.x = pg8::cvt_pk_bf16(hv[0], hv[1]); w.y = pg8::cvt_pk_bf16(hv[2], hv[3]); w.z = pg8::cvt_pk_bf16(hv[4], hv[5]); w.w = pg8::cvt_pk_bf16(hv[6], hv[7]);
                *(pg8::u32x4*)(HM + (size_t)(row0 + ai * 128 + m * 16) * 512 + col0) = w;
            }
    }
};
struct EpiStoreOne {
    static constexpr bool PERM = true, AFTER_DRAIN = false;
    pg8::bf16_t* O; int ldc;
    __device__ __forceinline__ void operator()(const pg8::f32x4 (&acc)[2][2][4][2], const pg8::Unit& u, int wr, int wc, int fr, int fq) const {
        const int row0 = u.pm * 256 + wr * 64 + fr, col0 = u.pn * 256 + wc * 32 + 8 * fq;
#pragma unroll
        for (int ai = 0; ai < 2; ++ai)
#pragma unroll
            for (int m = 0; m < 4; ++m) { pg8::bf16_t* rowp = O + (size_t)(row0 + ai * 128 + m * 16) * ldc + col0;
#pragma unroll
                for (int bj = 0; bj < 2; ++bj) { const pg8::f32x4 v0 = acc[ai][bj][m][0], v1 = acc[ai][bj][m][1];
                    pg8::u32x4 w; w.x = pg8::cvt_pk_bf16(v0[0], v0[1]); w.y = pg8::cvt_pk_bf16(v0[2], v0[3]); w.z = pg8::cvt_pk_bf16(v1[0], v1[1]); w.w = pg8::cvt_pk_bf16(v1[2], v1[3]);
                    *(pg8::u32x4*)(rowp + bj * 128) = w; } }
    }
};
constexpr size_t WS_HM = WS_R1;
__device__ __forceinline__ void p5_moe_up(const Frame& F, const Args& a, int layer) {
    unsigned char* ws = a.ws;
    pg8::Gemm g{1024, 1024, 1024};
    const MoeSched S = make_moe_sched(F, layer, (const char*)(ws + WS_R3), (size_t)256 * 1024 * 2, (const char*)(ws + WS_WEXP), (size_t)256 * 1024 * 2, (size_t)1024 * 1024 * 2);
    EpiSwiGLU E{(pg8::bf16_t*)(ws + WS_HM)};
    pg8::gemm_phase<EpiSwiGLU, MoeSched, true, true>(F.lds, g, S, E);
}
__device__ __forceinline__ void p6_moe_down(const Frame& F, const Args& a, int layer) {
    unsigned char* ws = a.ws;
    pg8::Gemm g{512, 512, 512};
    const MoeSched S = make_moe_sched(F, layer, (const char*)(ws + WS_HM), (size_t)256 * 512 * 2, (const char*)(ws + WS_WEXP + 32 * MiB), (size_t)256 * 512 * 2, (size_t)1024 * 512 * 2);
    EpiStoreOne E{(pg8::bf16_t*)(ws + WS_R3), 1024};
    pg8::gemm_phase<EpiStoreOne, MoeSched, true, true>(F.lds, g, S, E);
}
constexpr size_t WS_H1 = WS_R1;
constexpr size_t WS_XC = WS_R1 + (size_t)16384 * 1792 * 2;
constexpr size_t WS_Q = WS_R3, WS_K = WS_R3 + (size_t)16384 * 768 * 2, WS_VT = WS_R3 + (size_t)2 * 16384 * 768 * 2;
constexpr size_t WS_KT = WS_WEXP + 24 * MiB;
constexpr int CQ_P = 400, CQ_XM = 0, CQ_XC = 68 * CQ_P, CQ_W = CQ_XC + 64 * CQ_P;
static_assert(CQ_W + 192 * CQ_P <= LDSCTL_OFF, "conv/qkv LDS map");

__device__ __forceinline__ void cq_stage_w(const Frame& F, const bf16* W  ) {
    for (int i = F.tid; i < 192 * 24; i += NTHREADS) { const int r = i / 24, c = i % 24; *(LAS v4u*)(F.lds + CQ_W + r * CQ_P + c * 16) = *(const GAS v4u*)(W + r * 192 + c * 8); }
}
template <bool TRANS>
__device__ __forceinline__ void cq_gemm(const Frame& F, int xoff  , f32x4 (&acc)[6]) {
    const int cq = F.lane & 15, g = F.lane >> 4, wr = F.wave & 3, wc = F.wave >> 2;
    bf16x8 xf[6];
#pragma unroll
    for (int ks = 0; ks < 6; ++ks) xf[ks] = *(const LAS bf16x8*)(F.lds + xoff + (16 * wr + cq) * CQ_P + (32 * ks + 8 * g) * 2);
#pragma unroll
    for (int nt = 0; nt < 6; ++nt) {
        f32x4 a = {0.f, 0.f, 0.f, 0.f};
#pragma unroll
        for (int ks = 0; ks < 6; ++ks) {
            const bf16x8 wf = *(const LAS bf16x8*)(F.lds + CQ_W + (96 * wc + 16 * nt + cq) * CQ_P + (32 * ks + 8 * g) * 2);
            a = TRANS ? MFMA16(wf, xf[ks], a) : MFMA16(xf[ks], wf, a);
        }
        acc[nt] = a;
    }
}
__device__ __forceinline__ void p10_convqkv(const Frame& F, const Args& a) {
    unsigned char* ws = a.ws;
    const bf16* H1 = (const bf16*)(ws + WS_H1); bf16* XCg = (bf16*)(ws + WS_XC); bf16* Qg = (bf16*)(ws + WS_Q); bf16* Kg = (bf16*)(ws + WS_K); bf16* VTg = (bf16*)(ws + WS_VT); bf16* KTg = (bf16*)(ws + WS_KT);
    const bf16* WQKV = (const bf16*)(ws + WS_WQKV); const float* cw = a.in[10]; const float* cbias = a.in[11];
    const int cq = F.lane & 15, g = F.lane >> 4, wr = F.wave & 3, wc = F.wave >> 2;
    for (int u = blockIdx.x; u < 1024; u += gridDim.x) {
        const int h = u & 3, tile = u >> 2, t0 = tile * 64, b = t0 >> 11, s0 = t0 & 2047, bh = b * 4 + h;
        for (int i = F.tid; i < 68 * 24; i += NTHREADS) { const int r = i / 24, c = i % 24, s = s0 - 2 + r; v4u v = {0u, 0u, 0u, 0u};
            if (s >= 0 && s < 2048) v = *(const GAS v4u*)(H1 + (size_t)(b * 2048 + s) * 1792 + h * 192 + c * 8);
            *(LAS v4u*)(F.lds + CQ_XM + r * CQ_P + c * 16) = v; }
        cq_stage_w(F, WQKV + (size_t)(0 * 4 + h) * 192 * 192);
        __syncthreads();
        if (F.tid < 384) {
            const int c = F.tid % 192, half = F.tid / 192, ch = h * 192 + c;
            const float w0 = cw[0 * 768 + ch], w1 = cw[1 * 768 + ch], w2 = cw[2 * 768 + ch], w3 = cw[3 * 768 + ch], w4 = cw[4 * 768 + ch], bs = cbias[ch];
            const LAS unsigned short* xm = (const LAS unsigned short*)(F.lds + CQ_XM) + c; LAS unsigned short* xc = (LAS unsigned short*)(F.lds + CQ_XC) + c;
            float x0 = bf2f(xm[(32 * half + 0) * 200]), x1 = bf2f(xm[(32 * half + 1) * 200]), x2 = bf2f(xm[(32 * half + 2) * 200]), x3 = bf2f(xm[(32 * half + 3) * 200]);
            for (int r = 32 * half; r < 32 * half + 32; ++r) {
                const float x4 = bf2f(xm[(r + 4) * 200]);
                const float y = bs + x0 * w0 + x1 * w1 + x2 * w2 + x3 * w3 + x4 * w4;
                const unsigned short o = (unsigned short)f2bf(y / (1.f + __expf(-y)));
                xc[r * 200] = o; XCg[(size_t)(t0 + r) * 768 + ch] = o;
                x0 = x1; x1 = x2; x2 = x3; x3 = x4;
            }
        }
        __syncthreads();
        f32x4 acc[6];
        cq_gemm<true>(F, CQ_XC, acc);
        { bf16* dst = Qg + ((size_t)bh * 2048 + s0 + 16 * wr + cq) * 192 + 96 * wc + 4 * g;
#pragma unroll
          for (int nt = 0; nt < 6; ++nt) { v2u w; w.x = cvtpk(acc[nt][0], acc[nt][1]); w.y = cvtpk(acc[nt][2], acc[nt][3]); *(GAS v2u*)(dst + 16 * nt) = w; } }
        __syncthreads();
        cq_stage_w(F, WQKV + (size_t)(1 * 4 + h) * 192 * 192);
        __syncthreads();
        cq_gemm<true>(F, CQ_XC, acc);
        { bf16* dst = Kg + ((size_t)bh * 2048 + s0 + 16 * wr + cq) * 192 + 96 * wc + 4 * g;
#pragma unroll
          for (int nt = 0; nt < 6; ++nt) { v2u w; w.x = cvtpk(acc[nt][0], acc[nt][1]); w.y = cvtpk(acc[nt][2], acc[nt][3]); *(GAS v2u*)(dst + 16 * nt) = w; } }
        cq_gemm<false>(F, CQ_XC, acc);
        { bf16* dst = KTg + ((size_t)bh * 192 + 96 * wc + cq) * 2048 + s0 + 16 * wr + 4 * g;
#pragma unroll
          for (int nt = 0; nt < 6; ++nt) { v2u w; w.x = cvtpk(acc[nt][0], acc[nt][1]); w.y = cvtpk(acc[nt][2], acc[nt][3]); *(GAS v2u*)(dst + (size_t)16 * nt * 2048) = w; } }
        __syncthreads();
        cq_stage_w(F, WQKV + (size_t)(2 * 4 + h) * 192 * 192);
        __syncthreads();
        cq_gemm<false>(F, CQ_XM + 2 * CQ_P, acc);
        { bf16* dst = VTg + ((size_t)bh * 192 + 96 * wc + cq) * 2048 + s0 + 16 * wr + 4 * g;
#pragma unroll
          for (int nt = 0; nt < 6; ++nt) { v2u w; w.x = cvtpk(acc[nt][0], acc[nt][1]); w.y = cvtpk(acc[nt][2], acc[nt][3]); *(GAS v2u*)(dst + (size_t)16 * nt * 2048) = w; } }
        __syncthreads();
    }
}
constexpr size_t WS_HF = WS_XBF, WS_HB = WS_WEXP;
constexpr int ML_Q = 0, ML_K = 25600, ML_KT = 51200, ML_VT = 75776, ML_VW = 84480, ML_CT = 92672, ML_N = 118272, ML_G = 119040, ML_DW = ML_G + 1536;
static_assert(ML_DW + 512 <= LDSCTL_OFF, "mLSTM LDS map");
struct MlPre { v4u q[3], k[3], kt[3], vt; };
__device__ __forceinline__ void ml_issue(const Frame& F, MlPre& P, const bf16* Qb, const bf16* Kb, const bf16* KTb, const bf16* VTb, int sb) {
    int tid = F.tid; asm volatile("" : "+v"(tid));
#pragma unroll
    for (int i = 0; i < 3; ++i) { const int pc = tid + 512 * i, r = pc / 24, c = pc % 24;
        P.q[i] = *(const GAS v4u*)(Qb + (size_t)(sb + r) * 192 + c * 8); P.k[i] = *(const GAS v4u*)(Kb + (size_t)(sb + r) * 192 + c * 8);
        const int d = pc >> 3, c8 = pc & 7; P.kt[i] = *(const GAS v4u*)(KTb + (size_t)d * 2048 + sb + c8 * 8); }
    { const int e = tid >> 3, c8 = tid & 7; P.vt = *(const GAS v4u*)(VTb + (size_t)e * 2048 + sb + c8 * 8); }
}
__device__ __forceinline__ void ml_commit(const Frame& F, const MlPre& P) {
    int tid = F.tid; asm volatile("" : "+v"(tid));
#pragma unroll
    for (int i = 0; i < 3; ++i) { const int pc = tid + 512 * i, r = pc / 24, c = pc % 24;
        *(LAS v4u*)(F.lds + ML_Q + r * 400 + c * 16) = P.q[i]; *(LAS v4u*)(F.lds + ML_K + r * 400 + c * 16) = P.k[i];
        const int d = pc >> 3, c8 = pc & 7; *(LAS v4u*)(F.lds + ML_KT + d * 128 + ((c8 ^ (d & 7)) << 4)) = P.kt[i]; }
    { const int e = tid >> 3, c8 = tid & 7; LAS v2u* dst = (LAS v2u*)(F.lds + ML_VT + e * 136 + c8 * 16); dst[0] = (v2u){P.vt.x, P.vt.y}; dst[1] = (v2u){P.vt.z, P.vt.w}; }
}
__device__ __forceinline__ void mlstm_item(const Frame& F, const Args& a, int b, int h, int dir, int es) {
    unsigned char* ws = a.ws;
    const int bh = b * 4 + h, cq0 = F.lane & 15, g0 = F.lane >> 4, tt = F.wave & 3, eh = F.wave >> 2;
    const bf16* Qb = (const bf16*)(ws + WS_Q) + (size_t)bh * 2048 * 192; const bf16* Kb = (const bf16*)(ws + WS_K) + (size_t)bh * 2048 * 192;
    const bf16* KTb = (const bf16*)(ws + WS_KT) + (size_t)bh * 192 * 2048; const bf16* VTb = (const bf16*)(ws + WS_VT) + ((size_t)bh * 192 + 64 * es) * 2048;
    const float* G = (const float*)(ws + WS_ROUTE + RT_GATES) + (size_t)b * 2048 * 16;
    bf16* Hout = (bf16*)(ws + (dir ? WS_HB : WS_HF)) + (size_t)b * 2048 * 768 + h * 192 + 64 * es;
    LAS float* gcum = (LAS float*)(F.lds + ML_G); LAS float* ga = gcum + 64; LAS float* gdec = gcum + 128; LAS float* gw = gcum + 192; LAS float* gsc = gcum + 256;
    LAS float* nvec = (LAS float*)(F.lds + ML_N); LAS float* denw = (LAS float*)(F.lds + ML_DW) + F.wave * 16;
    for (int i = F.tid; i < 64 * 100; i += NTHREADS) ((LAS unsigned*)(F.lds + ML_CT))[i] = 0u;
    if (F.tid < 192) nvec[F.tid] = 0.f;
    f32x4 cacc[6];
#pragma unroll
    for (int i = 0; i < 6; ++i) cacc[i] = (f32x4){0.f, 0.f, 0.f, 0.f};
    MlPre P;
    { const int c0 = dir ? 31 : 0; ml_issue(F, P, Qb, Kb, KTb, VTb, 64 * c0); ml_commit(F, P); }
    for (int ci = 0; ci < 32; ++ci) {
        const int c = dir ? 31 - ci : ci, sb = 64 * c;
        int cq = cq0, g = g0; asm volatile("" : "+v"(cq), "+v"(g));
        if (F.wave == 0) {
            const float* gp = G + (size_t)(sb + F.lane) * 16 + dir * 8 + h;
            const float ig = gp[0], fg = gp[4];
            float lf = fminf(fg, 0.f) - log1pf(__expf(-fabsf(fg)));
            float cum = lf;
#pragma unroll
            for (int o = 1; o < 64; o <<= 1) { const float v = dir ? __shfl_down(cum, o) : __shfl_up(cum, o); const bool ok = dir ? (F.lane + o < 64) : (F.lane >= o); cum += ok ? v : 0.f; }
            const float total = __shfl(cum, dir ? 0 : 63);
            gcum[F.lane] = cum; ga[F.lane] = ig - cum; gdec[F.lane] = __expf(cum); gw[F.lane] = __expf(total - cum + ig);
            if (F.lane == 0) gsc[0] = __expf(total);
        }
        if (ci < 31) ml_issue(F, P, Qb, Kb, KTb, VTb, 64 * (dir ? c - 1 : c + 1));
        __syncthreads();
        { const int e = F.tid >> 3, c8 = F.tid & 7; const LAS v2u* src = (const LAS v2u*)(F.lds + ML_VT + e * 136 + c8 * 16); const v2u lo = src[0], hi = src[1];
          const f32x4 w0 = *(const LAS f32x4*)(gw + 8 * c8), w1 = *(const LAS f32x4*)(gw + 8 * c8 + 4);
          v4u o; o.x = cvtpk(bflo(lo.x) * w0.x, bfhi(lo.x) * w0.y); o.y = cvtpk(bflo(lo.y) * w0.z, bfhi(lo.y) * w0.w); o.z = cvtpk(bflo(hi.x) * w1.x, bfhi(hi.x) * w1.y); o.w = cvtpk(bflo(hi.y) * w1.z, bfhi(hi.y) * w1.w);
          *(LAS v4u*)(F.lds + ML_VW + e * 128 + ((c8 ^ (e & 7)) << 4)) = o; }
        bf16x8 qf[6];
#pragma unroll
        for (int ks = 0; ks < 6; ++ks) qf[ks] = *(const LAS bf16x8*)(F.lds + ML_Q + (16 * tt + cq) * 400 + (32 * ks + 8 * g) * 2);
        f32x4 sacc[4];
#pragma unroll
        for (int st = 0; st < 4; ++st) { f32x4 z = {0.f, 0.f, 0.f, 0.f};
#pragma unroll
            for (int ks = 0; ks < 6; ++ks) { const bf16x8 kf = *(const LAS bf16x8*)(F.lds + ML_K + (16 * st + cq) * 400 + (32 * ks + 8 * g) * 2); z = MFMA16(kf, qf[ks], z); }
            sacc[st] = z; __builtin_amdgcn_sched_barrier(0); }
        const int tl = 16 * tt + cq; const float cum_t = gcum[tl], dec_t = gdec[tl];
        float dpart = 0.f;
#pragma unroll
        for (int st = 0; st < 4; ++st) { const f32x4 a4 = *(const LAS f32x4*)(ga + 16 * st + 4 * g);
#pragma unroll
            for (int i = 0; i < 4; ++i) { const int sl = 16 * st + 4 * g + i; const bool ok = dir ? (sl >= tl) : (sl <= tl);
                const float p = ok ? sacc[st][i] * __expf(cum_t + a4[i]) : 0.f; sacc[st][i] = p; dpart += p; } }
        dpart += __shfl_xor(dpart, 16); dpart += __shfl_xor(dpart, 32);
        __builtin_amdgcn_sched_barrier(0);
        float qn = 0.f;
#pragma unroll
        for (int ks = 0; ks < 6; ++ks) { const f32x4 n0 = *(const LAS f32x4*)(nvec + 32 * ks + 8 * g), n1 = *(const LAS f32x4*)(nvec + 32 * ks + 8 * g + 4); const v4u qw = __builtin_bit_cast(v4u, qf[ks]);
            qn += bflo(qw.x) * n0.x + bfhi(qw.x) * n0.y + bflo(qw.y) * n0.z + bfhi(qw.y) * n0.w + bflo(qw.z) * n1.x + bfhi(qw.z) * n1.y + bflo(qw.w) * n1.z + bfhi(qw.w) * n1.w; }
        qn += __shfl_xor(qn, 16); qn += __shfl_xor(qn, 32);
        if (g == 0) denw[cq] = dpart + dec_t * qn;
        __builtin_amdgcn_sched_barrier(0);
        f32x4 o[2];
#pragma unroll
        for (int nt = 0; nt < 2; ++nt) { f32x4 z = {0.f, 0.f, 0.f, 0.f};
#pragma unroll
            for (int ks = 0; ks < 6; ++ks) { const bf16x8 cf = *(const LAS bf16x8*)(F.lds + ML_CT + (32 * eh + 16 * nt + cq) * 400 + (32 * ks + 8 * g) * 2); z = MFMA16(qf[ks], cf, z); }
            o[nt] = z; __builtin_amdgcn_sched_barrier(0); }
        { const f32x4 d4 = *(const LAS f32x4*)(gdec + 16 * tt + 4 * g);
#pragma unroll
          for (int nt = 0; nt < 2; ++nt) o[nt] = o[nt] * d4; }
#pragma unroll
        for (int kk = 0; kk < 2; ++kk) {
            v4u pw; pw.x = cvtpk(sacc[2 * kk][0], sacc[2 * kk][1]); pw.y = cvtpk(sacc[2 * kk][2], sacc[2 * kk][3]); pw.z = cvtpk(sacc[2 * kk + 1][0], sacc[2 * kk + 1][1]); pw.w = cvtpk(sacc[2 * kk + 1][2], sacc[2 * kk + 1][3]);
            const bf16x8 pf = __builtin_bit_cast(bf16x8, pw);
#pragma unroll
            for (int nt = 0; nt < 2; ++nt) { const int va = ML_VT + (32 * eh + 16 * nt + cq) * 136 + (32 * kk + 4 * g) * 2;
                const s16x4 lo = *(const LAS s16x4*)(F.lds + va), hi = *(const LAS s16x4*)(F.lds + va + 32);
                o[nt] = MFMA16(pf, __builtin_shufflevector(lo, hi, 0, 1, 2, 3, 4, 5, 6, 7), o[nt]); }
        }
        __builtin_amdgcn_sched_barrier(0);
        { const f32x4 dn = *(const LAS f32x4*)(denw + 4 * g);
#pragma unroll
          for (int i = 0; i < 4; ++i) { const float inv = 1.f / fmaxf(fabsf(dn[i]), 1.f); bf16* hp = Hout + (size_t)(sb + 16 * tt + 4 * g + i) * 768 + 32 * eh + cq;
              hp[0] = (bf16)f2bf(o[0][i] * inv); hp[16] = (bf16)f2bf(o[1][i] * inv); } }
        __syncthreads();
        { const int nt4 = F.wave & 3, dh = F.wave >> 2; const float cdec = gsc[0];
          bf16x8 vf[2];
#pragma unroll
          for (int kk = 0; kk < 2; ++kk) { const int er = 16 * nt4 + cq; vf[kk] = *(const LAS bf16x8*)(F.lds + ML_VW + er * 128 + (((4 * kk + g) ^ (er & 7)) << 4)); }
#pragma unroll
          for (int j = 0; j < 6; ++j) { const int dr = 96 * dh + 16 * j + cq; f32x4 z = cacc[j] * cdec;
#pragma unroll
              for (int kk = 0; kk < 2; ++kk) { const bf16x8 kf = *(const LAS bf16x8*)(F.lds + ML_KT + dr * 128 + (((4 * kk + g) ^ (dr & 7)) << 4)); z = MFMA16(kf, vf[kk], z); }
              cacc[j] = z; __builtin_amdgcn_sched_barrier(0); } }
        float nnew = 0.f;
        if (F.tid < 192) { const int d = F.tid; float acc = gsc[0] * nvec[d];
#pragma unroll
            for (int c8 = 0; c8 < 8; ++c8) { const v4u kw = *(const LAS v4u*)(F.lds + ML_KT + d * 128 + ((c8 ^ (d & 7)) << 4)); const f32x4 w0 = *(const LAS f32x4*)(gw + 8 * c8), w1 = *(const LAS f32x4*)(gw + 8 * c8 + 4);
                acc += bflo(kw.x) * w0.x + bfhi(kw.x) * w0.y + bflo(kw.y) * w0.z + bfhi(kw.y) * w0.w + bflo(kw.z) * w1.x + bfhi(kw.z) * w1.y + bflo(kw.w) * w1.z + bfhi(kw.w) * w1.w; }
            nnew = acc; }
        __syncthreads();
        { const int nt4 = F.wave & 3, dh = F.wave >> 2;
#pragma unroll
          for (int j = 0; j < 6; ++j) { v2u w; w.x = cvtpk(cacc[j][0], cacc[j][1]); w.y = cvtpk(cacc[j][2], cacc[j][3]); *(LAS v2u*)(F.lds + ML_CT + (16 * nt4 + cq) * 400 + (96 * dh + 16 * j + 4 * g) * 2) = w; } }
        if (F.tid < 192) nvec[F.tid] = nnew;
        if (ci < 31) ml_commit(F, P);
    }
    __syncthreads();
}
__device__ __forceinline__ void p11_mlstm(const Frame& F, const Args& a) {
    bf16* H1 = (bf16*)(a.ws + WS_H1); const bf16* memkv = (const bf16*)(a.ws + WS_MEMKV);
    for (int L = blockIdx.x; L < 256; L += gridDim.x) {
        if (L < 192) { const int es = L % 3, r = L / 3; mlstm_item(F, a, r >> 3, (r >> 1) & 3, r & 1, es); }
        else { const int su = L - 192; memattn_unit(F, H1, 1792, 768, memkv, su >> 3, (su & 7) >> 1, (su >> 3) * 2048 + (su & 1) * 1024, 1024); }
        __syncthreads();
    }
}
__device__ __forceinline__ void p12_mlstm_out(const Frame& F, const Args& a) {
    unsigned char* ws = a.ws; bf16* H1 = (bf16*)(ws + WS_H1); const bf16* XC = (const bf16*)(ws + WS_XC); const bf16* HF = (const bf16*)(ws + WS_HF); const bf16* HB = (const bf16*)(ws + WS_HB);
    const float* ng = a.in[14]; const float* sk = a.in[15];
    const int gw = blockIdx.x * NWAVES + F.wave, NGW = gridDim.x * NWAVES;
    for (int it = gw; it < NTOK * 4; it += NGW) {
        const int t = it >> 2, h = it & 3;
        float x[3]; float sm = 0.f;
#pragma unroll
        for (int j = 0; j < 3; ++j) { const size_t i = (size_t)t * 768 + h * 192 + F.lane + 64 * j; x[j] = bf2f(HF[i]) + bf2f(HB[i]); sm += x[j]; }
        const float mean = wave_sum(sm) * (1.f / 192.f); float qv = 0.f;
#pragma unroll
        for (int j = 0; j < 3; ++j) { x[j] -= mean; qv += x[j] * x[j]; }
        const float rstd = 1.f / sqrtf(wave_sum(qv) * (1.f / 192.f) + LN_EPS);
#pragma unroll
        for (int j = 0; j < 3; ++j) { const int ch = h * 192 + F.lane + 64 * j; const float z = bf2f(H1[(size_t)t * 1792 + 1024 + ch]);
            const float y = (x[j] * rstd * ng[ch] + sk[ch] * bf2f(XC[(size_t)t * 768 + ch])) * (z / (1.f + __expf(-z)));
            H1[(size_t)t * 1792 + ch] = (bf16)f2bf(y); }
    }
}
__global__ void __launch_bounds__(NTHREADS, 2) mega(Args args) {
    extern __shared__ __attribute__((aligned(16))) unsigned char lds[];
    Frame F;
    F.lds = (LAS unsigned char*)lds; F.MISC = (volatile LAS unsigned*)(F.lds + MISC_OFF);
    F.tid = threadIdx.x; F.lane = F.tid & 63; F.wave = __builtin_amdgcn_readfirstlane(F.tid >> 6);
    F.G = gridDim.x; { const int bx = blockIdx.x; F.vcu = (F.G % 8 == 0) ? (bx % 8) * (F.G / 8) + bx / 8 : bx; }
    unsigned char* ws = args.ws;
    F.ctl = (gu32*)(ws + WS_CTL);
    for (int u = F.tid; u < (LDS_BYTES - LDSCTL_OFF) / 4; u += NTHREADS) ((LAS unsigned*)(F.lds + LDSCTL_OFF))[u] = 0u;
    __syncthreads();
    const int lo = args.ph_lo, hi = args.ph_hi;
    const bool single = (hi - lo) <= 1;
    XcdBarrier bar; bar.bar = (unsigned*)(F.ctl + CW_BAR) + args.li * XCD_BAR_WORDS; bar.x = 0; bar.st = nullptr;
    if (!single) bar = xcd_barrier_post((unsigned*)(F.ctl + CW_BAR) + args.li * XCD_BAR_WORDS, F.MISC + 8);
#ifndef PH_MASK
#define PH_MASK 0xffffffffu
#endif
#define IN(k) (((PH_MASK >> (k)) & 1u) && lo <= (k) && (k) < hi)
#define SEAM(k) do { if (IN(k) && IN((k) + 1)) xcd_barrier(bar); } while (0)

    if (IN(0)) { p0_prologue(F, args); } SEAM(0);
    if (IN(1)) {
        pg8::Gemm g{1024, 1024, 1024};
        pg8::DenseSched S{(const char*)(ws + WS_XBF), (const char*)(ws + WS_WIN0), (const char*)(ws + WS_MEMN), (const char*)(ws + WS_WMKV), 64, 10, 8, 2, F.G, (int)blockIdx.x, (size_t)256 * 1024 * 2, (size_t)256 * 1024 * 2};
        pg8::EpiStore E{(pg8::bf16_t*)(ws + WS_R1), 2560, (pg8::bf16_t*)(ws + WS_MEMKV), 512};
        pg8::gemm_phase<pg8::EpiStore, pg8::DenseSched, true, true>(F.lds, g, S, E);
    } SEAM(1);
    if (IN(2)) { p2_attention(F, args); } SEAM(2);
    if (IN(3)) {
        pg8::Gemm g{2560, 1024, 1024};
        pg8::DenseSched S{(const char*)(ws + WS_R1), (const char*)(ws + WS_WOUT), nullptr, nullptr, 64, 4, 0, 0, F.G, (int)blockIdx.x, (size_t)256 * 2560 * 2, (size_t)256 * 1024 * 2};
        pg8::EpiStore E{(pg8::bf16_t*)(ws + WS_R3), 1024, nullptr, 0};
        pg8::gemm_phase<pg8::EpiStore, pg8::DenseSched, true, true>(F.lds, g, S, E);
    } SEAM(3);
    if (IN(4)) { p4_ln_route(F, args, 0, args.in[0], args.out); } SEAM(4);
    if (IN(5)) { p4b_scatter(F, args, 0); } SEAM(5);
    if (IN(6)) { p5_moe_up(F, args, 0); } SEAM(6);
    if (IN(7)) { p6_moe_down(F, args, 0); } SEAM(7);
    if (IN(8)) { p7_combine_ln(F, args, 0, args.out); } SEAM(8);
    if (IN(9)) {
        pg8::Gemm g{1024, 1024, 1024};
        pg8::DenseSched S{(const char*)(ws + WS_XBF), (const char*)(ws + WS_WIN1), nullptr, nullptr, 64, 7, 0, 0, F.G, (int)blockIdx.x, (size_t)256 * 1024 * 2, (size_t)256 * 1024 * 2};
        pg8::EpiStore E{(pg8::bf16_t*)(ws + WS_H1), 1792, nullptr, 0};
        pg8::gemm_phase<pg8::EpiStore, pg8::DenseSched, true, true>(F.lds, g, S, E);
    } SEAM(9);
    if (IN(10)) { p10_convqkv(F, args); } SEAM(10);
    if (IN(11)) { p11_mlstm(F, args); } SEAM(11);
    if (IN(12)) { p12_mlstm_out(F, args); } SEAM(12);
    if (IN(13)) {
        pg8::Gemm g{1792, 1024, 1024};
        pg8::DenseSched S{(const char*)(ws + WS_H1), (const char*)(ws + WS_WOUT + (size_t)1024 * 1024 * 2), nullptr, nullptr, 64, 4, 0, 0, F.G, (int)blockIdx.x, (size_t)256 * 1792 * 2, (size_t)256 * 1024 * 2};
        pg8::EpiStore E{(pg8::bf16_t*)(ws + WS_R3), 1024, nullptr, 0};
        pg8::gemm_phase<pg8::EpiStore, pg8::DenseSched, true, true>(F.lds, g, S, E);
        __syncthreads();
        p0_experts(F, args.in[19] + (size_t)16 * 1024 * 512, args.in[20] + (size_t)16 * 1024 * 512, args.in[21] + (size_t)16 * 512 * 1024, (bf16*)(ws + WS_WEXP), (bf16*)(ws + WS_WEXP + 32 * MiB), F.vcu * NWAVES + F.wave, F.G * NWAVES);
    } SEAM(13);
    if (IN(14)) { p4_ln_route(F, args, 1, args.out, args.out); } SEAM(14);
    if (IN(15)) { p4b_scatter(F, args, 1); } SEAM(15);
    if (IN(16)) { p5_moe_up(F, args, 1); } SEAM(16);
    if (IN(17)) { p6_moe_down(F, args, 1); } SEAM(17);
    if (IN(18)) { p7_combine_ln(F, args, 1, args.out); }
#undef IN
#undef SEAM
}
}
extern "C" void kernel_launch(void* const* d_in, const int* in_sizes, int n_in, void* d_out, int out_size, void* d_ws, size_t ws_size, hipStream_t stream) {
    static int grid = 0;
    if (grid == 0) {
        int dev = 0, cus = 0, per_cu = 0;
        if (hipGetDevice(&dev) != hipSuccess || hipDeviceGetAttribute(&cus, hipDeviceAttributeMultiprocessorCount, dev) != hipSuccess) { grid = -1; return; }
        if (hipFuncSetAttribute((const void*)mk::mega, hipFuncAttributeMaxDynamicSharedMemorySize, mk::LDS_BYTES) != hipSuccess) { grid = -1; return; }
        if (hipOccupancyMaxActiveBlocksPerMultiprocessor(&per_cu, (const void*)mk::mega, mk::NTHREADS, mk::LDS_BYTES) != hipSuccess || per_cu < 1) { fprintf(stderr, "kernel_launch: occupancy query reports %d workgroups per CU\n", per_cu); }
        (void)hipGetLastError();
        grid = cus;
    }
    if (grid < 0 || n_in != 22 || ws_size < mk::WS_END) return;
    (void)hipMemsetAsync((char*)d_ws + mk::WS_CTL, 0, mk::CTL_ZERO_BYTES, stream);
    mk::Args a{};
    for (int i = 0; i < 22; ++i) a.in[i] = (const float*)d_in[i];
    a.out = (float*)d_out; a.ws = (unsigned char*)d_ws; a.ph_lo = 0; a.ph_hi = 19; a.li = 0;
    hipLaunchKernelGGL(mk::mega, dim3(grid), dim3(mk::NTHREADS), mk::LDS_BYTES, stream, a);
}
```
